# Optimizing an MI355X kernel written in HIP

```python
import jax, jax.numpy as jnp
from jax import lax
import numpy as np

D_MODEL = 2048
BATCH = 2
SEQ = 8192
DEPTH = 1

CHUNK = 64
MEM_LEN = 256
D_MIX = D_MODEL
D_A = D_MIX // 2
D_B = D_MIX - D_A
A_HEADS = 8
A_HEAD_DIM = D_A // A_HEADS
SGU_BLOCK = 128
POOL_WINDOWS = (2, 4, 8, 16)
B_GROUPS = len(POOL_WINDOWS)
B_GROUP_DIM = D_B // B_GROUPS
D_IN = 2 * D_A + D_B
XATTN_HEADS = 4
XATTN_HEAD_DIM = D_MODEL // XATTN_HEADS
PEER_HEADS = 8
PEER_N_KEYS = 128
PEER_N_EXPERTS = PEER_N_KEYS * PEER_N_KEYS
PEER_TOPK = 16
PEER_D_KEY = 256
PEER_HALF = PEER_D_KEY // 2
PEER_TOKEN_BLOCK = 128
EPS = 1e-6

kernel_name = "hybrid_sgu_pool_peer_block"


def rmsnorm(x, g):
    xf = x.astype(jnp.float32)
    xf = xf * lax.rsqrt(jnp.mean(xf * xf, axis=-1, keepdims=True) + EPS)
    return xf.astype(x.dtype) * g


def layernorm(x, g, b):
    xf = x.astype(jnp.float32)
    mu = jnp.mean(xf, axis=-1, keepdims=True)
    xc = xf - mu
    xf = xc * lax.rsqrt(jnp.mean(xc * xc, axis=-1, keepdims=True) + EPS)
    return xf.astype(x.dtype) * g + b


def spatial_gating_unit(u, v, ln_g, ln_b, w_s, b_s):
    Bn, S, _ = u.shape
    nblk = S // SGU_BLOCK
    v = layernorm(v, ln_g, ln_b).reshape(Bn, nblk, SGU_BLOCK, A_HEADS, A_HEAD_DIM)
    pos = jnp.arange(SGU_BLOCK)
    mask = (pos[None, :] // CHUNK) <= (pos[:, None] // CHUNK)
    w = jnp.where(mask[None], w_s, jnp.zeros_like(w_s))
    mixed = jnp.einsum('hij,bnjhd->bnihd', w, v) + b_s.T[None, None, :, :, None]
    return u * mixed.reshape(Bn, S, D_A)


def multiscale_pool(xb, w_pool, pool_scale):
    Bn, S, _ = xb.shape
    xg = xb.reshape(Bn, S, B_GROUPS, B_GROUP_DIM)
    xf = xg.astype(jnp.float32)
    cs = jnp.cumsum(xf, axis=1)
    cs = jnp.concatenate([jnp.zeros_like(cs[:, :1]), cs], axis=1)
    t = jnp.arange(S)
    pooled = []
    for g, w in enumerate(POOL_WINDOWS):
        cs_g = cs[:, :, g]
        start = jnp.maximum(t + 1 - w, 0)
        window_sum = cs_g[:, 1:] - cs_g[:, start]
        count = (t + 1 - start).astype(jnp.float32)
        pooled.append(window_sum / count[None, :, None])
    pooled = jnp.stack(pooled, axis=2)
    y = (pooled - xf).astype(xb.dtype)
    y = jnp.einsum('bsgc,gcd->bsgd', y, w_pool)
    return y.reshape(Bn, S, D_B) * pool_scale


def memory_cross_attention(h, mem, g_q, g_mem, w_q, w_kv, w_o):
    Bn, S, D = h.shape
    n = rmsnorm(h, g_q)
    m = rmsnorm(mem, g_mem)
    q = (n @ w_q).reshape(Bn, S, XATTN_HEADS, XATTN_HEAD_DIM)
    kv = m @ w_kv
    k = kv[..., :D_MODEL].reshape(Bn, -1, XATTN_HEADS, XATTN_HEAD_DIM)
    v = kv[..., D_MODEL:].reshape(Bn, -1, XATTN_HEADS, XATTN_HEAD_DIM)
    scores = jnp.einsum('bshd,bmhd->bhsm', q, k).astype(jnp.float32) * (XATTN_HEAD_DIM ** -0.5)
    p = jax.nn.softmax(scores, axis=-1).astype(v.dtype)
    o = jnp.einsum('bhsm,bmhd->bshd', p, v).reshape(Bn, S, D)
    return o @ w_o


def peer_retrieve(n, w_query, sub_keys):
    T = n.shape[0]
    q = (n @ w_query).reshape(T, PEER_HEADS, 2, PEER_HALF)
    s = jnp.einsum('thpc,hpkc->thpk', q, sub_keys).astype(jnp.float32)
    top_s, top_i = lax.top_k(s, PEER_TOPK)
    cand_s = top_s[:, :, 0, :, None] + top_s[:, :, 1, None, :]
    cand_i = top_i[:, :, 0, :, None] * PEER_N_KEYS + top_i[:, :, 1, None, :]
    cand_s = cand_s.reshape(T, PEER_HEADS, PEER_TOPK * PEER_TOPK)
    cand_i = cand_i.reshape(T, PEER_HEADS, PEER_TOPK * PEER_TOPK)
    best_s, pos = lax.top_k(cand_s, PEER_TOPK)
    idx = jnp.take_along_axis(cand_i, pos, axis=-1)
    gates = jax.nn.softmax(best_s, axis=-1)
    return idx, gates


def peer_experts(n, idx, gates, u_table, v_table):
    T, D = n.shape
    nb = T // PEER_TOKEN_BLOCK

    def block(args):
        xb, ib, gb = args
        ue = jnp.take(u_table, ib, axis=0)
        a = jax.nn.gelu(jnp.einsum('td,thkd->thk', xb, ue), approximate=False)
        a = a * gb.astype(xb.dtype)
        ve = jnp.take(v_table, ib, axis=0)
        return jnp.einsum('thk,thkd->td', a, ve)

    out = lax.map(block, (n.reshape(nb, PEER_TOKEN_BLOCK, D),
                          idx.reshape(nb, PEER_TOKEN_BLOCK, PEER_HEADS, PEER_TOPK),
                          gates.reshape(nb, PEER_TOKEN_BLOCK, PEER_HEADS, PEER_TOPK)))
    return out.reshape(T, D)


def setup_inputs(seed: int = 0) -> dict:
    key = jax.random.key(seed)
    ks = jax.random.split(key, 24)
    f32 = jnp.float32
    D = D_MODEL

    def nrm(k, shape, scale):
        return jax.random.normal(k, shape, f32) * scale

    def gain(k, shape):
        return 1.0 + 0.05 * jax.random.normal(k, shape, f32)

    return {
        "x": nrm(ks[0], (BATCH, SEQ, D), 1.0),
        "mem": nrm(ks[1], (BATCH, MEM_LEN, D), 1.0),
        "g_mix": gain(ks[2], (DEPTH, D)),
        "w_in": nrm(ks[3], (DEPTH, D, D_IN), D ** -0.5),
        "sgu_ln_g": gain(ks[4], (DEPTH, D_A)),
        "sgu_ln_b": nrm(ks[5], (DEPTH, D_A), 0.02),
        "sgu_w": nrm(ks[6], (DEPTH, A_HEADS, SGU_BLOCK, SGU_BLOCK), 0.5 * SGU_BLOCK ** -0.5),
        "sgu_b": gain(ks[7], (DEPTH, A_HEADS, SGU_BLOCK)),
        "pool_w": nrm(ks[8], (DEPTH, B_GROUPS, B_GROUP_DIM, B_GROUP_DIM), B_GROUP_DIM ** -0.5),
        "pool_scale": 0.5 + 0.05 * jax.random.normal(ks[9], (DEPTH, D_B), f32),
        "w_out": nrm(ks[10], (DEPTH, D_MIX, D), D_MIX ** -0.5),
        "g_xattn": gain(ks[11], (DEPTH, D)),
        "g_mem": gain(ks[12], (DEPTH, D)),
        "xattn_w_q": nrm(ks[13], (DEPTH, D, D), D ** -0.5),
        "xattn_w_kv": nrm(ks[14], (DEPTH, D, 2 * D), D ** -0.5),
        "xattn_w_o": nrm(ks[15], (DEPTH, D, D), D ** -0.5),
        "g_peer": gain(ks[16], (DEPTH, D)),
        "peer_w_query": nrm(ks[17], (DEPTH, D, PEER_HEADS * PEER_D_KEY), D ** -0.5),
        "peer_sub_keys": nrm(ks[18], (DEPTH, PEER_HEADS, 2, PEER_N_KEYS, PEER_HALF), PEER_HALF ** -0.5),
        "peer_u": nrm(ks[19], (DEPTH, PEER_N_EXPERTS, D), D ** -0.5),
        "peer_v": nrm(ks[20], (DEPTH, PEER_N_EXPERTS, D), 0.7),
        "g_final": gain(ks[21], (D,)),
    }


def reference(x, mem, g_mix, w_in, sgu_ln_g, sgu_ln_b, sgu_w, sgu_b, pool_w, pool_scale, w_out,
              g_xattn, g_mem, xattn_w_q, xattn_w_kv, xattn_w_o,
              g_peer, peer_w_query, peer_sub_keys, peer_u, peer_v, g_final):
    Bn, S, D = x.shape
    h = x
    for l in range(DEPTH):
        n = rmsnorm(h, g_mix[l])
        proj = n @ w_in[l]
        u = jax.nn.gelu(proj[..., :D_A], approximate=False)
        v = jax.nn.gelu(proj[..., D_A:2 * D_A], approximate=False)
        xp = proj[..., 2 * D_A:]
        ya = spatial_gating_unit(u, v, sgu_ln_g[l], sgu_ln_b[l], sgu_w[l], sgu_b[l])
        yb = multiscale_pool(xp, pool_w[l], pool_scale[l])
        h = h + jnp.concatenate([ya, yb], axis=-1) @ w_out[l]
        h = h + memory_cross_attention(h, mem, g_xattn[l], g_mem[l],
                                       xattn_w_q[l], xattn_w_kv[l], xattn_w_o[l])
        n = rmsnorm(h, g_peer[l]).reshape(Bn * S, D)
        idx, gates = peer_retrieve(n, peer_w_query[l], peer_sub_keys[l])
        h = h + peer_experts(n, idx, gates, peer_u[l], peer_v[l]).reshape(Bn, S, D)
    return rmsnorm(h, g_final)
```

```cpp
#include <hip/hip_runtime.h>
#include <math.h>

#define TT 16384
#define DM 2048
#define SEQ 8192
#define EPSV 1e-6f

__device__ __forceinline__ float gelu_f(float v) { return 0.5f * v * (1.0f + erff(v * 0.70710678118654752f)); }

__device__ __forceinline__ float block_sum(float v, float* red) {
  for (int o = 32; o >= 1; o >>= 1) v += __shfl_xor(v, o);
  int w = threadIdx.x >> 6, l = threadIdx.x & 63;
  __syncthreads();
  if (l == 0) red[w] = v;
  __syncthreads();
  float s = 0.f;
  for (int i = 0; i < (int)(blockDim.x >> 6); ++i) s += red[i];
  return s;
}

__global__ void k_rmsnorm(const float* __restrict__ x, const float* __restrict__ g, float* __restrict__ out) {
  __shared__ float red[8];
  const float* xr = x + (size_t)blockIdx.x * DM; float* orow = out + (size_t)blockIdx.x * DM;
  float v[8]; float ss = 0.f;
#pragma unroll
  for (int i = 0; i < 8; ++i) { v[i] = xr[threadIdx.x + i * 256]; ss += v[i] * v[i]; }
  ss = block_sum(ss, red);
  float r = rsqrtf(ss / DM + EPSV);
#pragma unroll
  for (int i = 0; i < 8; ++i) orow[threadIdx.x + i * 256] = v[i] * r * g[threadIdx.x + i * 256];
}

struct GemmP { const float* A; const float* B; float* C; const float* R; int lda, ldb, ldc, K, transB, zdiv; long a1, a2, b1, b2, c1, c2; };
__global__ void __launch_bounds__(256) k_gemm(GemmP p) {
  __shared__ float As[16][65]; __shared__ float Bs[16][65];
  int z = blockIdx.z; long oa = (long)(z / p.zdiv) * p.a1 + (long)(z % p.zdiv) * p.a2, ob = (long)(z / p.zdiv) * p.b1 + (long)(z % p.zdiv) * p.b2, oc = (long)(z / p.zdiv) * p.c1 + (long)(z % p.zdiv) * p.c2;
  const float* A = p.A + oa; const float* B = p.B + ob; float* C = p.C + oc; const float* R = p.R ? p.R + oc : nullptr;
  int m0 = blockIdx.y * 64, n0 = blockIdx.x * 64, tid = threadIdx.x, tx = tid & 15, ty = tid >> 4;
  float acc[4][4] = {};
  for (int k0 = 0; k0 < p.K; k0 += 16) {
    for (int i = tid; i < 1024; i += 256) { int r = i >> 4, c = i & 15; As[c][r] = A[(long)(m0 + r) * p.lda + k0 + c]; }
    if (p.transB) { for (int i = tid; i < 1024; i += 256) { int r = i >> 4, c = i & 15; Bs[c][r] = B[(long)(n0 + r) * p.ldb + k0 + c]; } }
    else { for (int i = tid; i < 1024; i += 256) { int r = i >> 6, c = i & 63; Bs[r][c] = B[(long)(k0 + r) * p.ldb + n0 + c]; } }
    __syncthreads();
#pragma unroll
    for (int k = 0; k < 16; ++k) {
      float a[4], b[4];
#pragma unroll
      for (int i = 0; i < 4; ++i) { a[i] = As[k][ty * 4 + i]; b[i] = Bs[k][tx * 4 + i]; }
#pragma unroll
      for (int i = 0; i < 4; ++i)
#pragma unroll
        for (int j = 0; j < 4; ++j) acc[i][j] += a[i] * b[j];
    }
    __syncthreads();
  }
#pragma unroll
  for (int i = 0; i < 4; ++i)
#pragma unroll
    for (int j = 0; j < 4; ++j) { long o = (long)(m0 + ty * 4 + i) * p.ldc + n0 + tx * 4 + j; C[o] = acc[i][j] + (R ? R[o] : 0.f); }
}

__global__ void k_gelu(float* proj) {
  long i = (long)blockIdx.x * 256 + threadIdx.x; long t = i / 2048, c = i % 2048;
  float* p = proj + t * 3072 + c; *p = gelu_f(*p);
}
__global__ void k_layernorm(float* proj, const float* __restrict__ g, const float* __restrict__ b) {
  __shared__ float red[8];
  float* v = proj + (size_t)blockIdx.x * 3072 + 1024;
  float x[4]; float s = 0.f;
#pragma unroll
  for (int i = 0; i < 4; ++i) { x[i] = v[threadIdx.x + i * 256]; s += x[i]; }
  s = block_sum(s, red); float mu = s / 1024.f; float q = 0.f;
#pragma unroll
  for (int i = 0; i < 4; ++i) { x[i] -= mu; q += x[i] * x[i]; }
  q = block_sum(q, red); float r = rsqrtf(q / 1024.f + EPSV);
#pragma unroll
  for (int i = 0; i < 4; ++i) { int c = threadIdx.x + i * 256; v[c] = x[i] * r * g[c] + b[c]; }
}
__global__ void __launch_bounds__(256) k_sgu(const float* __restrict__ proj, const float* __restrict__ w, const float* __restrict__ bs, float* __restrict__ cat) {
  __shared__ float vs[128][128];
  int blk = blockIdx.x, h = blockIdx.y, tid = threadIdx.x;
  for (int i = tid; i < 128 * 128; i += 256) { int j = i >> 7, d = i & 127; vs[j][d] = proj[(size_t)(blk * 128 + j) * 3072 + 1024 + h * 128 + d]; }
  __syncthreads();
  int d = tid & 127;
  for (int i = tid >> 7; i < 128; i += 2) {
    const float* wr = w + ((size_t)h * 128 + i) * 128; float a = 0.f; int jmax = (i < 64) ? 64 : 128;
    for (int j = 0; j < jmax; ++j) a += wr[j] * vs[j][d];
    a += bs[h * 128 + i];
    size_t t = (size_t)blk * 128 + i;
    cat[t * 2048 + h * 128 + d] = proj[t * 3072 + h * 128 + d] * a;
  }
}
__global__ void k_pool(const float* __restrict__ proj, float* __restrict__ y) {
  long i = (long)blockIdx.x * 256 + threadIdx.x; int t = (int)(i >> 10), c = (int)(i & 1023); int g = c >> 8, w = 2 << g;
  int pos = t & (SEQ - 1); int start = pos + 1 - w; if (start < 0) start = 0; int cnt = pos + 1 - start;
  float s = 0.f; for (int q = start; q <= pos; ++q) s += proj[(size_t)(t - pos + q) * 3072 + 2048 + c];
  y[i] = s / (float)cnt - proj[(size_t)t * 3072 + 2048 + c];
}
__global__ void k_scale_yb(float* cat, const float* __restrict__ ps) {
  long i = (long)blockIdx.x * 256 + threadIdx.x; int t = (int)(i >> 10), c = (int)(i & 1023);
  cat[(size_t)t * 2048 + 1024 + c] *= ps[c];
}
__global__ void k_softmax256(float* s, float scale) {
  int row = blockIdx.x * 4 + (threadIdx.x >> 6), l = threadIdx.x & 63; float* r = s + (size_t)row * 256;
  float v[4]; float m = -INFINITY;
#pragma unroll
  for (int i = 0; i < 4; ++i) { v[i] = r[l + 64 * i] * scale; m = fmaxf(m, v[i]); }
  for (int o = 32; o >= 1; o >>= 1) m = fmaxf(m, __shfl_xor(m, o));
  float sum = 0.f;
#pragma unroll
  for (int i = 0; i < 4; ++i) { v[i] = expf(v[i] - m); sum += v[i]; }
  for (int o = 32; o >= 1; o >>= 1) sum += __shfl_xor(sum, o);
  float inv = 1.f / sum;
#pragma unroll
  for (int i = 0; i < 4; ++i) r[l + 64 * i] = v[i] * inv;
}
__global__ void __launch_bounds__(256) k_topk(const float* __restrict__ s, int* __restrict__ idx, float* __restrict__ gates) {
  __shared__ float ts[4][2][16]; __shared__ int ti[4][2][16]; __shared__ float bsv[4][16]; __shared__ int bid[4][16];
  int w = threadIdx.x >> 6, lane = threadIdx.x & 63; int gw = blockIdx.x * 4 + w; int t = gw >> 3, h = gw & 7;
  for (int p = 0; p < 2; ++p) {
    const float* sp = s + (size_t)t * 2048 + h * 256 + p * 128;
    float v0 = sp[lane], v1 = sp[lane + 64];
    for (int r = 0; r < 16; ++r) {
      float m; int mi; if (v0 >= v1) { m = v0; mi = lane; } else { m = v1; mi = lane + 64; }
      for (int o = 32; o >= 1; o >>= 1) { float om = __shfl_xor(m, o); int oi = __shfl_xor(mi, o); if (om > m || (om == m && oi < mi)) { m = om; mi = oi; } }
      if (lane == 0) { ts[w][p][r] = m; ti[w][p][r] = mi; }
      if (mi == lane) v0 = -INFINITY; if (mi == lane + 64) v1 = -INFINITY;
    }
  }
  __syncthreads();
  float c[4];
#pragma unroll
  for (int q = 0; q < 4; ++q) { int cc = lane * 4 + q; c[q] = ts[w][0][cc >> 4] + ts[w][1][cc & 15]; }
  for (int r = 0; r < 16; ++r) {
    float m = c[0]; int mi = lane * 4;
    if (c[1] > m) { m = c[1]; mi = lane * 4 + 1; } if (c[2] > m) { m = c[2]; mi = lane * 4 + 2; } if (c[3] > m) { m = c[3]; mi = lane * 4 + 3; }
    for (int o = 32; o >= 1; o >>= 1) { float om = __shfl_xor(m, o); int oi = __shfl_xor(mi, o); if (om > m || (om == m && oi < mi)) { m = om; mi = oi; } }
    if (lane == 0) { bsv[w][r] = m; bid[w][r] = ti[w][0][mi >> 4] * 128 + ti[w][1][mi & 15]; }
    if ((mi >> 2) == lane) { int q = mi & 3; if (q == 0) c[0] = -INFINITY; if (q == 1) c[1] = -INFINITY; if (q == 2) c[2] = -INFINITY; if (q == 3) c[3] = -INFINITY; }
  }
  __syncthreads();
  if (lane < 16) {
    float mx = bsv[w][0]; float sum = 0.f; for (int r = 0; r < 16; ++r) sum += expf(bsv[w][r] - mx);
    gates[(size_t)gw * 16 + lane] = expf(bsv[w][lane] - mx) / sum; idx[(size_t)gw * 16 + lane] = bid[w][lane];
  }
}
__global__ void __launch_bounds__(256) k_experts(const float* __restrict__ gp, const float* h2, const int* __restrict__ idx, const float* __restrict__ gates,
                                                  const float* __restrict__ U, const float* __restrict__ V, const float* __restrict__ gf, float* out) {
  int lane = threadIdx.x & 63; int t = blockIdx.x * 4 + (threadIdx.x >> 6);
  float4 n[8], acc[8]; float s0 = 0.f;
#pragma unroll
  for (int j = 0; j < 8; ++j) { n[j] = *(const float4*)(h2 + (size_t)t * 2048 + j * 256 + lane * 4); acc[j] = make_float4(0.f, 0.f, 0.f, 0.f);
    s0 += n[j].x * n[j].x + n[j].y * n[j].y + n[j].z * n[j].z + n[j].w * n[j].w; }
  for (int o = 32; o >= 1; o >>= 1) s0 += __shfl_xor(s0, o);
  { float r0 = rsqrtf(s0 / 2048.f + EPSV);
#pragma unroll
    for (int j = 0; j < 8; ++j) { float4 g4 = *(const float4*)(gp + j * 256 + lane * 4); n[j].x *= r0 * g4.x; n[j].y *= r0 * g4.y; n[j].z *= r0 * g4.z; n[j].w *= r0 * g4.w; } }
  for (int e = 0; e < 128; ++e) {
    int id = idx[(size_t)t * 128 + e]; float g = gates[(size_t)t * 128 + e];
    const float* ur = U + (size_t)id * 2048 + lane * 4; const float* vr = V + (size_t)id * 2048 + lane * 4;
    float dot = 0.f;
#pragma unroll
    for (int j = 0; j < 8; ++j) { float4 u = *(const float4*)(ur + j * 256); dot += u.x * n[j].x + u.y * n[j].y + u.z * n[j].z + u.w * n[j].w; }
    for (int o = 32; o >= 1; o >>= 1) dot += __shfl_xor(dot, o);
    float a = gelu_f(dot) * g;
#pragma unroll
    for (int j = 0; j < 8; ++j) { float4 v = *(const float4*)(vr + j * 256); acc[j].x += a * v.x; acc[j].y += a * v.y; acc[j].z += a * v.z; acc[j].w += a * v.w; }
  }
  float ss = 0.f;
#pragma unroll
  for (int j = 0; j < 8; ++j) { float4 hh = *(const float4*)(h2 + (size_t)t * 2048 + j * 256 + lane * 4); acc[j].x += hh.x; acc[j].y += hh.y; acc[j].z += hh.z; acc[j].w += hh.w;
    ss += acc[j].x * acc[j].x + acc[j].y * acc[j].y + acc[j].z * acc[j].z + acc[j].w * acc[j].w; }
  for (int o = 32; o >= 1; o >>= 1) ss += __shfl_xor(ss, o);
  float r = rsqrtf(ss / 2048.f + EPSV);
#pragma unroll
  for (int j = 0; j < 8; ++j) { float4 g4 = *(const float4*)(gf + j * 256 + lane * 4); float4 o; o.x = acc[j].x * r * g4.x; o.y = acc[j].y * r * g4.y; o.z = acc[j].z * r * g4.z; o.w = acc[j].w * r * g4.w;
    *(float4*)(out + (size_t)t * 2048 + j * 256 + lane * 4) = o; }
}

static void gemm(hipStream_t st, const float* A, int lda, const float* B, int ldb, int transB, float* C, int ldc, const float* R, int M, int N, int K,
                 int nz = 1, int zdiv = 1, long a1 = 0, long a2 = 0, long b1 = 0, long b2 = 0, long c1 = 0, long c2 = 0) {
  GemmP p{}; p.A = A; p.B = B; p.C = C; p.R = R; p.lda = lda; p.ldb = ldb; p.ldc = ldc; p.K = K; p.transB = transB; p.zdiv = zdiv; p.a1 = a1; p.a2 = a2; p.b1 = b1; p.b2 = b2; p.c1 = c1; p.c2 = c2;
  hipLaunchKernelGGL(k_gemm, dim3(N / 64, M / 64, nz), dim3(256), 0, st, p);
}

extern "C" void kernel_launch(void* const* d_in, const int* in_sizes, int n_in, void* d_out, int out_size, void* d_ws, size_t ws_size, hipStream_t stream) {
  const float* x = (const float*)d_in[0]; const float* mem = (const float*)d_in[1]; const float* g_mix = (const float*)d_in[2]; const float* w_in = (const float*)d_in[3];
  const float* ln_g = (const float*)d_in[4]; const float* ln_b = (const float*)d_in[5]; const float* sgu_w = (const float*)d_in[6]; const float* sgu_b = (const float*)d_in[7];
  const float* pool_w = (const float*)d_in[8]; const float* pool_scale = (const float*)d_in[9]; const float* w_out = (const float*)d_in[10];
  const float* g_xattn = (const float*)d_in[11]; const float* g_mem = (const float*)d_in[12]; const float* w_q = (const float*)d_in[13]; const float* w_kv = (const float*)d_in[14]; const float* w_o = (const float*)d_in[15];
  const float* g_peer = (const float*)d_in[16]; const float* w_query = (const float*)d_in[17]; const float* sub_keys = (const float*)d_in[18]; const float* peer_u = (const float*)d_in[19]; const float* peer_v = (const float*)d_in[20];
  const float* g_final = (const float*)d_in[21];
  float* ws = (float*)d_ws; float* out = (float*)d_out;
  float* R0 = ws;
  float* R1 = R0 + (size_t)TT * 3072;
  float* S0 = R1 + (size_t)TT * 2048;
  float* ybuf = S0;
  float* mnorm = S0;
  float* kv = S0 + (size_t)512 * 2048;
  int* idx = (int*)(S0 + (size_t)TT * 1024);
  float* gates = S0 + (size_t)TT * 1024 + (size_t)TT * 128;
  float* h = out;
  hipLaunchKernelGGL(k_rmsnorm, dim3(TT), dim3(256), 0, stream, x, g_mix, R1);
  gemm(stream, R1, 2048, w_in, 3072, 0, R0, 3072, nullptr, TT, 3072, 2048);
  hipLaunchKernelGGL(k_gelu, dim3(TT * 2048 / 256), dim3(256), 0, stream, R0);
  hipLaunchKernelGGL(k_layernorm, dim3(TT), dim3(256), 0, stream, R0, ln_g, ln_b);
  hipLaunchKernelGGL(k_sgu, dim3(TT / 128, 8), dim3(256), 0, stream, (const float*)R0, sgu_w, sgu_b, R1);
  hipLaunchKernelGGL(k_pool, dim3(TT * 1024 / 256), dim3(256), 0, stream, (const float*)R0, ybuf);
  gemm(stream, ybuf, 1024, pool_w, 256, 0, R1 + 1024, 2048, nullptr, TT, 256, 256, 4, 1, 256, 0, 65536, 0, 256, 0);
  hipLaunchKernelGGL(k_scale_yb, dim3(TT * 1024 / 256), dim3(256), 0, stream, R1, pool_scale);
  gemm(stream, R1, 2048, w_out, 2048, 0, h, 2048, x, TT, 2048, 2048);
  hipLaunchKernelGGL(k_rmsnorm, dim3(TT), dim3(256), 0, stream, (const float*)h, g_xattn, R1);
  hipLaunchKernelGGL(k_rmsnorm, dim3(512), dim3(256), 0, stream, mem, g_mem, mnorm);
  gemm(stream, mnorm, 2048, w_kv, 4096, 0, kv, 4096, nullptr, 512, 4096, 2048);
  float* q = R0;
  float* sc = R0 + (size_t)TT * 2048;
  gemm(stream, R1, 2048, w_q, 2048, 0, q, 2048, nullptr, TT, 2048, 2048);
  gemm(stream, q, 2048, kv, 4096, 1, sc, 256, nullptr, SEQ, 256, 512, 8, 4, (long)SEQ * 2048, 512, (long)256 * 4096, 512, (long)4 * SEQ * 256, (long)SEQ * 256);
  hipLaunchKernelGGL(k_softmax256, dim3(8 * SEQ / 4), dim3(256), 0, stream, sc, 0.044194173824159216f);
  gemm(stream, sc, 256, kv + 2048, 4096, 0, R1, 2048, nullptr, SEQ, 512, 256, 8, 4, (long)4 * SEQ * 256, (long)SEQ * 256, (long)256 * 4096, 512, (long)SEQ * 2048, 512);
  gemm(stream, R1, 2048, w_o, 2048, 0, h, 2048, h, TT, 2048, 2048);
  hipLaunchKernelGGL(k_rmsnorm, dim3(TT), dim3(256), 0, stream, (const float*)h, g_peer, R1);
  float* pq = R0; float* pscore = R1;
  gemm(stream, R1, 2048, w_query, 2048, 0, pq, 2048, nullptr, TT, 2048, 2048);
  gemm(stream, pq, 2048, sub_keys, 128, 1, pscore, 2048, nullptr, TT, 128, 128, 16, 1, 128, 0, 16384, 0, 128, 0);
  hipLaunchKernelGGL(k_topk, dim3(TT * 8 / 4), dim3(256), 0, stream, (const float*)pscore, idx, gates);
  hipLaunchKernelGGL(k_experts, dim3(TT / 4), dim3(256), 0, stream, g_peer, (const float*)h, (const int*)idx, (const float*)gates, peer_u, peer_v, g_final, out);
}
```

```cpp
#define HYBRID_CUT 9
#define ONE_LAUNCH 0
#include <hip/hip_runtime.h>
#include <cstdio>
#include <math.h>

#define LAS __attribute__((address_space(3)))
typedef _Float16 h16;
typedef _Float16 half8 __attribute__((ext_vector_type(8)));
typedef _Float16 half4 __attribute__((ext_vector_type(4)));
typedef _Float16 half2v __attribute__((ext_vector_type(2)));
typedef float f32x4 __attribute__((ext_vector_type(4)));
typedef float f32x2 __attribute__((ext_vector_type(2)));
typedef unsigned u32x4 __attribute__((ext_vector_type(4)));
typedef unsigned u32x2 __attribute__((ext_vector_type(2)));

constexpr int T_ = 16384, D_ = 2048, SEQ_ = 8192;
constexpr float EPS_ = 1e-6f;
constexpr size_t MiB = 1ull << 20;
constexpr size_t O_W1T   = 0;
constexpr size_t O_W3T   = O_W1T   + 12 * MiB;
constexpr size_t O_WKVT  = O_W3T   + 8 * MiB;
constexpr size_t O_WQ16  = O_WKVT  + 16 * MiB;
constexpr size_t O_WOT   = O_WQ16  + 8 * MiB;
constexpr size_t O_WQRY  = O_WOT   + 8 * MiB;
constexpr size_t O_WQST  = O_WQRY  + 8 * MiB;
constexpr size_t O_WQKT  = O_WQST  + 8 * MiB;
constexpr size_t O_WVOT  = O_WQKT  + 8 * MiB;
constexpr size_t O_WINZ  = O_WVOT  + 8 * MiB;
constexpr size_t O_WPOOLT= O_WINZ  + 4 * MiB;
constexpr size_t O_SKBD  = O_WPOOLT+ 1 * MiB;
constexpr size_t O_WSGU  = O_SKBD  + 1 * MiB;
constexpr size_t O_M16   = O_WSGU  + 1 * MiB;
constexpr size_t O_KV16  = O_M16   + 2 * MiB;
constexpr size_t O_U8    = O_KV16  + 4 * MiB;
constexpr size_t O_V8    = O_U8    + 32 * MiB;
constexpr size_t O_SU    = O_V8    + 32 * MiB;
constexpr size_t O_SV    = O_SU    + 1 * MiB;
constexpr size_t O_RSTD1 = O_SV    + 1 * MiB;
constexpr size_t O_LNST  = O_RSTD1 + 1 * MiB;
constexpr size_t O_SSQ2  = O_LNST  + 2 * MiB;
constexpr size_t O_SSQ3  = O_SSQ2  + 2 * MiB;
constexpr size_t O_CTL   = O_SSQ3  + 2 * MiB;
constexpr size_t O_RA    = O_CTL   + 1 * MiB;
constexpr size_t O_RB    = O_RA    + 64 * MiB;
constexpr size_t WS_END  = O_RB    + 128 * MiB;
constexpr size_t CTL_BYTES = 64 * 1024;

constexpr int LDS_BYTES = 144 * 1024;
constexpr int NTHREADS = 512;

__device__ __forceinline__ float wave_sum(float v) {
  v += __builtin_bit_cast(float, __builtin_amdgcn_update_dpp(0, __builtin_bit_cast(int, v), 0xB1, 0xf, 0xf, true));
  v += __builtin_bit_cast(float, __builtin_amdgcn_update_dpp(0, __builtin_bit_cast(int, v), 0x4E, 0xf, 0xf, true));
  v += __builtin_bit_cast(float, __builtin_amdgcn_update_dpp(0, __builtin_bit_cast(int, v), 0x141, 0xf, 0xf, true));
  v += __builtin_bit_cast(float, __builtin_amdgcn_update_dpp(0, __builtin_bit_cast(int, v), 0x140, 0xf, 0xf, true));
  v += __builtin_bit_cast(float, __builtin_amdgcn_update_dpp(0, __builtin_bit_cast(int, v), 0x142, 0xa, 0xf, false));
  v += __builtin_bit_cast(float, __builtin_amdgcn_update_dpp(0, __builtin_bit_cast(int, v), 0x143, 0xc, 0xf, false));
  return __builtin_bit_cast(float, __builtin_amdgcn_readlane(__builtin_bit_cast(int, v), 63));
}
__device__ __forceinline__ float wave_max(float v) {
  for (int o = 32; o >= 1; o >>= 1) v = fmaxf(v, __shfl_xor(v, o));
  return v;
}
__device__ __forceinline__ unsigned pk_h2(float lo, float hi) { half2v r; r.x = (h16)lo; r.y = (h16)hi; return __builtin_bit_cast(unsigned, r); }
__device__ __forceinline__ float gelu_f(float v) { return 0.5f * v * (1.0f + erff(v * 0.70710678118654752f)); }
__device__ __forceinline__ f32x2 gelu_pk(f32x2 v) {
    const f32x2 av = __builtin_elementwise_abs(v), d = av * 0.2316418882f + 1.0f;
    f32x2 t; t.x = __builtin_amdgcn_rcpf(d.x); t.y = __builtin_amdgcn_rcpf(d.y);
    f32x2 q = t * 0.5307027145f + (-0.7265760135f); q = q * t + 0.7107068705f; q = q * t + (-0.142248368f); q = q * t + 0.127414796f; q = q * t;
    const f32x2 s = (v * v) * (-0.72134752044f);
    f32x2 e; e.x = __builtin_amdgcn_exp2f(s.x); e.y = __builtin_amdgcn_exp2f(s.y);
    const f32x2 m = v * (q * e), r = v - m;
    f32x2 o; o.x = v.x < 0.f ? m.x : r.x; o.y = v.y < 0.f ? m.y : r.y; return o;
}
namespace pg {
constexpr int BM = 256, BK = 64, HALF = 128, HTB = HALF * BK * 2, STAGE_BYTES = 8 * HTB, NXCD = 8, WGM = 8;

__host__ __device__ __forceinline__ int lds_byte(int r, int c) { const int st = (r >> 4) * 2 + (c >> 5), rr = r & 15, cc = c & 31, ob = rr * 64 + cc * 2; return st * 1024 + (ob ^ (((ob >> 9) & 1) << 5)); }
__host__ __device__ __forceinline__ void stage_rc(int b, int& R, int& C) { const int st = b / 1024, sb = b % 1024, swz = sb ^ (((sb >> 9) & 1) << 5); R = (st >> 1) * 16 + swz / 64; C = (st & 1) * 32 + (swz % 64) / 2; }
__host__ __device__ __forceinline__ int perm32(int rho) { const int n = rho >> 4, i = rho & 15; return 8 * (i >> 2) + 4 * n + (i & 3); }

struct Unit { int pm, pn; };
struct Gemm { const h16* A; const h16* Bt; int lda, ldb, K, bdiv; long bstride; };

struct StaticOrder {
    int nM, nN, nwg, G, c;
    __device__ void init(int nM_, int nN_, int G_, int c_) { nM = nM_; nN = nN_; nwg = nM * nN; G = G_; c = c_; }
    __device__ bool next(int i, Unit& u) const {
        const long L = (long)i * G + c; if (L >= nwg) return false;
        int wgid = (int)L; { const int q = nwg / NXCD, r = nwg % NXCD, xcd = wgid % NXCD, off = wgid / NXCD; wgid = (xcd < r ? xcd * (q + 1) : r * (q + 1) + (xcd - r) * q) + off; }
        const int nig = WGM * nN, gid = wgid / nig, fm = gid * WGM, gsz = (nM - fm) < WGM ? (nM - fm) : WGM;
        u.pm = fm + ((wgid % nig) % gsz); u.pn = (wgid % nig) / gsz; return true;
    }
};
struct OneUnit { Unit u; __device__ bool next(int i, Unit& o) const { if (i != 0) return false; o = u; return true; } };

typedef f32x4 Acc[2][2][4][2];

template <class Epi, class Sched>
__device__ __forceinline__ void gemm_phase(LAS unsigned char* lds, const Gemm g, const Sched& S, const Epi& E) {
    const int tid = threadIdx.x, wid = __builtin_amdgcn_readfirstlane(tid >> 6), lane = tid & 63, wr = wid >> 2, wc = wid & 3, fr = lane & 15, fq = lane >> 4;
    const int K = g.K, nt = K / BK;
    unsigned voffA[2], voffB[2];
#pragma unroll
    for (int i = 0; i < 2; ++i) { int R, C; stage_rc(tid * 16 + i * 8192, R, C); const int Rb = Epi::PERM ? ((R & ~31) + perm32(R & 31)) : R;
        voffA[i] = (unsigned)(R * g.lda + C) * 2u; voffB[i] = (unsigned)(Rb * g.ldb + C) * 2u; }
    const size_t kstep = (size_t)(BK * 2);
    const size_t hstepA = (size_t)HALF * g.lda * 2, hstepB = (size_t)HALF * g.ldb * 2;
    const size_t tstepA = 2 * hstepA, tstepB = 2 * hstepB;
    const unsigned ldsw = (unsigned)wid * 1024u;
    const int aoff = lds_byte(wr * 64 + fr, fq * 8), boff = lds_byte(wc * 32 + fr, fq * 8);
#define PG_SA(b, h) (((b) * 2 + (h)) * HTB)
#define PG_SB(b, h) ((4 + (b) * 2 + (h)) * HTB)
#define PG_STAGE(bufoff, gbase, voff) do { _Pragma("unroll") for (int _i = 0; _i < 2; ++_i) \
        __builtin_amdgcn_global_load_lds((const unsigned*)((const char*)(gbase) + (voff)[_i]), (LAS unsigned*)(lds + (bufoff) + ldsw + _i * 8192), 16, 0, 0); } while (0)
#define PG_LDA(dst, b, h) do { _Pragma("unroll") for (int m = 0; m < 4; ++m) _Pragma("unroll") for (int k = 0; k < 2; ++k) dst[m][k] = *(const LAS half8*)(lds + PG_SA(b, h) + aoff + m * 2048 + k * 1024); } while (0)
#define PG_LDB(dst, b, h) do { _Pragma("unroll") for (int n = 0; n < 2; ++n) _Pragma("unroll") for (int k = 0; k < 2; ++k) dst[n][k] = *(const LAS half8*)(lds + PG_SB(b, h) + boff + n * 2048 + k * 1024); } while (0)
#define PG_MMA(ai, bj, At, Bt) do { __builtin_amdgcn_s_setprio(1); _Pragma("unroll") for (int m = 0; m < 4; ++m) _Pragma("unroll") for (int n = 0; n < 2; ++n) _Pragma("unroll") for (int k = 0; k < 2; ++k) \
        acc[ai][bj][m][n] = __builtin_amdgcn_mfma_f32_16x16x32_f16(Bt[n][k], At[m][k], acc[ai][bj][m][n], 0, 0, 0); __builtin_amdgcn_s_setprio(0); } while (0)
#define PG_WAIT_V(n) asm volatile("s_waitcnt vmcnt(" #n ")" ::: "memory")
#define PG_WAIT_L(n) asm volatile("s_waitcnt lgkmcnt(" #n ")" ::: "memory")
#define PG_BAR __builtin_amdgcn_s_barrier()
#define PG_SCHED __builtin_amdgcn_sched_barrier(0)
    Unit cur, nxt; int ui = 0;
    if (!S.next(0, cur)) return;
    f32x4 acc[2][2][4][2];
#pragma unroll
    for (int a = 0; a < 2; ++a)
#pragma unroll
        for (int b = 0; b < 2; ++b)
#pragma unroll
            for (int m = 0; m < 4; ++m)
#pragma unroll
                for (int n = 0; n < 2; ++n) acc[a][b][m][n] = (f32x4){0.f, 0.f, 0.f, 0.f};
    half8 At[4][2], B0[2][2], B1[2][2];
    const char* cA = (const char*)g.A + (size_t)cur.pm * tstepA;
    const char* cB = (const char*)(g.Bt + (size_t)(cur.pm / g.bdiv) * g.bstride) + (size_t)cur.pn * tstepB;
    PG_STAGE(PG_SB(0, 0), cB, voffB); PG_STAGE(PG_SA(0, 0), cA, voffA); PG_STAGE(PG_SB(0, 1), cB + hstepB, voffB); PG_STAGE(PG_SA(0, 1), cA + hstepA, voffA);
    if (wr == 1) PG_BAR;
    PG_WAIT_V(4); PG_BAR;
    PG_STAGE(PG_SB(1, 0), cB + kstep, voffB); PG_STAGE(PG_SA(1, 0), cA + kstep, voffA); PG_STAGE(PG_SB(1, 1), cB + hstepB + kstep, voffB);
    PG_WAIT_V(6); PG_BAR;
    for (;;) {
        const bool has_next = S.next(ui + 1, nxt);
        const char* nA = has_next ? (const char*)g.A + (size_t)nxt.pm * tstepA : cA;
        const char* nB = has_next ? (const char*)(g.Bt + (size_t)(nxt.pm / g.bdiv) * g.bstride) + (size_t)nxt.pn * tstepB : cB;
        for (int t = 0; t < nt; t += 2) {
            const bool last = (t == nt - 2);
            const char* a1 = cA + (size_t)(t + 1) * kstep;
            const char* a2 = last ? nA : cA + (size_t)(t + 2) * kstep; const char* b2 = last ? nB : cB + (size_t)(t + 2) * kstep;
            const char* a3 = a2 + kstep; const char* b3 = b2 + kstep;
            PG_LDB(B0, 0, 0); PG_SCHED; PG_LDA(At, 0, 0); PG_STAGE(PG_SA(1, 1), a1 + hstepA, voffA);
            PG_WAIT_L(8); PG_BAR; PG_WAIT_L(0); PG_MMA(0, 0, At, B0); PG_BAR; PG_SCHED;
            PG_LDB(B1, 0, 1); PG_STAGE(PG_SB(0, 0), b2, voffB);
            PG_BAR; PG_WAIT_L(0); PG_MMA(0, 1, At, B1); PG_BAR;
            PG_LDA(At, 0, 1); PG_STAGE(PG_SA(0, 0), a2, voffA);
            PG_BAR; PG_WAIT_L(0); PG_MMA(1, 0, At, B0); PG_BAR; PG_SCHED;
            PG_STAGE(PG_SB(0, 1), b2 + hstepB, voffB);
            PG_WAIT_V(6); PG_BAR; PG_MMA(1, 1, At, B1); PG_BAR;
            PG_LDB(B0, 1, 0); PG_SCHED; PG_LDA(At, 1, 0); PG_STAGE(PG_SA(0, 1), a2 + hstepA, voffA);
            PG_WAIT_L(8); PG_BAR; PG_WAIT_L(0); PG_MMA(0, 0, At, B0); PG_BAR; PG_SCHED;
            PG_LDB(B1, 1, 1); PG_STAGE(PG_SB(1, 0), b3, voffB);
            PG_BAR; PG_WAIT_L(0); PG_MMA(0, 1, At, B1); PG_BAR;
            PG_LDA(At, 1, 1); PG_STAGE(PG_SA(1, 0), a3, voffA);
            PG_BAR; PG_WAIT_L(0); PG_MMA(1, 0, At, B0); PG_BAR; PG_SCHED;
            PG_STAGE(PG_SB(1, 1), b3 + hstepB, voffB);
            PG_WAIT_V(6); PG_BAR; PG_MMA(1, 1, At, B1); PG_BAR;
        }
        if constexpr (!Epi::AFTER_DRAIN) { E(acc, cur, wr, wc, fr, fq, lds + STAGE_BYTES); }
        if (!has_next) break;
#pragma unroll
        for (int a = 0; a < 2; ++a)
#pragma unroll
            for (int b = 0; b < 2; ++b)
#pragma unroll
                for (int m = 0; m < 4; ++m)
#pragma unroll
                    for (int n = 0; n < 2; ++n) acc[a][b][m][n] = (f32x4){0.f, 0.f, 0.f, 0.f};
        cur = nxt; cA = nA; cB = nB; ++ui;
    }
    PG_WAIT_V(0);
    if (wr == 0) PG_BAR;
    PG_BAR;
    if constexpr (Epi::AFTER_DRAIN) { E.fused(acc, cur, wr, wc, fr, fq, lds); }
#undef PG_SA
#undef PG_SB
#undef PG_STAGE
#undef PG_LDA
#undef PG_LDB
#undef PG_MMA
#undef PG_WAIT_V
#undef PG_WAIT_L
#undef PG_BAR
#undef PG_SCHED
}
}
namespace pg {
struct EpiHalf {
    static constexpr bool PERM = true, AFTER_DRAIN = false;
    h16* O; int ldc;
    __device__ __forceinline__ void operator()(const Acc& acc, const Unit& u, int wr, int wc, int fr, int fq, LAS unsigned char*) const {
        const int row0 = u.pm * BM + wr * 64 + fr, col0 = u.pn * BM + wc * 32 + 8 * fq;
#pragma unroll
        for (int ai = 0; ai < 2; ++ai)
#pragma unroll
            for (int m = 0; m < 4; ++m) { h16* rowp = O + (size_t)(row0 + ai * HALF + m * 16) * ldc + col0;
#pragma unroll
                for (int bj = 0; bj < 2; ++bj) { const f32x4 v0 = acc[ai][bj][m][0], v1 = acc[ai][bj][m][1];
                    u32x4 w; w.x = pk_h2(v0[0], v0[1]); w.y = pk_h2(v0[2], v0[3]); w.z = pk_h2(v1[0], v1[1]); w.w = pk_h2(v1[2], v1[3]);
                    *(u32x4*)(rowp + bj * HALF) = w; } }
    }
};
struct Epi1 {
    static constexpr bool PERM = true, AFTER_DRAIN = false;
    const float* rstd1; h16* UVZ; f32x2* lnst;
    __device__ __forceinline__ void operator()(const Acc& acc, const Unit& u, int wr, int wc, int fr, int fq, LAS unsigned char*) const {
        const int seg = u.pn >> 2, pnl = u.pn & 3;
        h16* base = UVZ + (size_t)seg * (16u << 20);
        const int row0 = u.pm * BM + wr * 64 + fr, col0 = pnl * BM + wc * 32 + 8 * fq;
#pragma unroll
        for (int ai = 0; ai < 2; ++ai)
#pragma unroll
            for (int m = 0; m < 4; ++m) { const int row = row0 + ai * HALF + m * 16; const float rs = rstd1[row]; h16* rowp = base + (size_t)row * 1024 + col0;
                float s = 0.f, ss = 0.f;
#pragma unroll
                for (int bj = 0; bj < 2; ++bj) { f32x4 v0 = acc[ai][bj][m][0] * rs, v1 = acc[ai][bj][m][1] * rs;
                    if (seg < 2) { f32x2 a = gelu_pk((f32x2){v0[0], v0[1]}), b = gelu_pk((f32x2){v0[2], v0[3]}), c = gelu_pk((f32x2){v1[0], v1[1]}), d = gelu_pk((f32x2){v1[2], v1[3]});
                        v0 = (f32x4){a.x, a.y, b.x, b.y}; v1 = (f32x4){c.x, c.y, d.x, d.y}; }
                    if (seg == 1) { s += (v0[0] + v0[1]) + (v0[2] + v0[3]) + (v1[0] + v1[1]) + (v1[2] + v1[3]);
                        ss += (v0[0] * v0[0] + v0[1] * v0[1]) + (v0[2] * v0[2] + v0[3] * v0[3]) + (v1[0] * v1[0] + v1[1] * v1[1]) + (v1[2] * v1[2] + v1[3] * v1[3]); }
                    u32x4 w; w.x = pk_h2(v0[0], v0[1]); w.y = pk_h2(v0[2], v0[3]); w.z = pk_h2(v1[0], v1[1]); w.w = pk_h2(v1[2], v1[3]);
                    *(u32x4*)(rowp + bj * HALF) = w; }
                if (seg == 1) { s += __shfl_xor(s, 16); s += __shfl_xor(s, 32); ss += __shfl_xor(ss, 16); ss += __shfl_xor(ss, 32);
                    if (fq == 0) lnst[(size_t)row * 16 + pnl * 4 + wc] = (f32x2){s, ss}; } }
    }
};
struct EpiRes {
    static constexpr bool PERM = true, AFTER_DRAIN = false;
    const float* res; float* out; h16* o16; float* ssq;
    __device__ __forceinline__ void operator()(const Acc& acc, const Unit& u, int wr, int wc, int fr, int fq, LAS unsigned char*) const {
        const int row0 = u.pm * BM + wr * 64 + fr, col0 = u.pn * BM + wc * 32 + 8 * fq;
#pragma unroll
        for (int ai = 0; ai < 2; ++ai)
#pragma unroll
            for (int m = 0; m < 4; ++m) { const int row = row0 + ai * HALF + m * 16; const size_t off = (size_t)row * 2048 + col0; float q = 0.f;
#pragma unroll
                for (int bj = 0; bj < 2; ++bj) { const f32x4 r0 = *(const f32x4*)(res + off + bj * HALF), r1 = *(const f32x4*)(res + off + bj * HALF + 4);
                    const f32x4 v0 = acc[ai][bj][m][0] + r0, v1 = acc[ai][bj][m][1] + r1;
                    *(f32x4*)(out + off + bj * HALF) = v0; *(f32x4*)(out + off + bj * HALF + 4) = v1;
                    u32x4 w; w.x = pk_h2(v0[0], v0[1]); w.y = pk_h2(v0[2], v0[3]); w.z = pk_h2(v1[0], v1[1]); w.w = pk_h2(v1[2], v1[3]);
                    *(u32x4*)(o16 + off + bj * HALF) = w;
                    q += (v0[0] * v0[0] + v0[1] * v0[1]) + (v0[2] * v0[2] + v0[3] * v0[3]) + (v1[0] * v1[0] + v1[1] * v1[1]) + (v1[2] * v1[2] + v1[3] * v1[3]); }
                q += __shfl_xor(q, 16); q += __shfl_xor(q, 32);
                if (fq == 0) ssq[(size_t)row * 32 + u.pn * 4 + wc] = q;
                asm volatile("" ::: "memory"); }
    }
};
__device__ __forceinline__ float row_rstd(const float* ssq, int row, int fq) {
    const float* p = ssq + (size_t)row * 32 + fq * 8; const f32x4 a = *(const f32x4*)p, b = *(const f32x4*)(p + 4);
    float q = ((a[0] + a[1]) + (a[2] + a[3])) + ((b[0] + b[1]) + (b[2] + b[3]));
    q += __shfl_xor(q, 16); q += __shfl_xor(q, 32);
    return rsqrtf(q * (1.0f / 2048.0f) + EPS_);
}
struct EpiSoftmax {
    static constexpr bool PERM = true, AFTER_DRAIN = true;
    const float* ssq2; h16* P;
    __device__ __forceinline__ void fused(Acc& acc, const Unit& u, int wr, int wc, int fr, int fq, LAS unsigned char* lds) const {
        LAS f32x2* X = (LAS f32x2*)lds;
        float mxs[2][4];
#pragma unroll
        for (int ai = 0; ai < 2; ++ai)
#pragma unroll
            for (int m = 0; m < 4; ++m) { const int rl = ai * HALF + wr * 64 + m * 16 + fr; const int row = u.pm * BM + rl;
                const float rs = row_rstd(ssq2, row, fq) * 0.044194173824159216f;
                float mx = -INFINITY;
#pragma unroll
                for (int bj = 0; bj < 2; ++bj)
#pragma unroll
                    for (int n = 0; n < 2; ++n) { f32x4 v = acc[ai][bj][m][n] * rs; acc[ai][bj][m][n] = v; mx = fmaxf(mx, fmaxf(fmaxf(v[0], v[1]), fmaxf(v[2], v[3]))); }
                mx = fmaxf(mx, __shfl_xor(mx, 16)); mx = fmaxf(mx, __shfl_xor(mx, 32));
                float l = 0.f;
#pragma unroll
                for (int bj = 0; bj < 2; ++bj)
#pragma unroll
                    for (int n = 0; n < 2; ++n) { f32x4 v = acc[ai][bj][m][n]; v[0] = __expf(v[0] - mx); v[1] = __expf(v[1] - mx); v[2] = __expf(v[2] - mx); v[3] = __expf(v[3] - mx);
                        acc[ai][bj][m][n] = v; l += (v[0] + v[1]) + (v[2] + v[3]); }
                l += __shfl_xor(l, 16); l += __shfl_xor(l, 32);
                if (fq == 0) X[rl * 4 + wc] = (f32x2){mx, l};
                mxs[ai][m] = mx; }
        asm volatile("s_waitcnt lgkmcnt(0)" ::: "memory"); __builtin_amdgcn_s_barrier(); asm volatile("" ::: "memory");
        const int col0 = u.pn * BM + wc * 32 + 8 * fq;
#pragma unroll
        for (int ai = 0; ai < 2; ++ai)
#pragma unroll
            for (int m = 0; m < 4; ++m) { const int rl = ai * HALF + wr * 64 + m * 16 + fr; const int row = u.pm * BM + rl;
                const f32x2 x0 = X[rl * 4 + 0], x1 = X[rl * 4 + 1], x2 = X[rl * 4 + 2], x3 = X[rl * 4 + 3];
                const float M = fmaxf(fmaxf(x0.x, x1.x), fmaxf(x2.x, x3.x));
                const float L = x0.y * __expf(x0.x - M) + x1.y * __expf(x1.x - M) + x2.y * __expf(x2.x - M) + x3.y * __expf(x3.x - M);
                const float f = __expf(mxs[ai][m] - M) / L;
                h16* rowp = P + (size_t)row * 1024 + col0;
#pragma unroll
                for (int bj = 0; bj < 2; ++bj) { const f32x4 v0 = acc[ai][bj][m][0] * f, v1 = acc[ai][bj][m][1] * f;
                    u32x4 w; w.x = pk_h2(v0[0], v0[1]); w.y = pk_h2(v0[2], v0[3]); w.z = pk_h2(v1[0], v1[1]); w.w = pk_h2(v1[2], v1[3]);
                    *(u32x4*)(rowp + bj * HALF) = w; } }
    }
};
struct EpiScore {
    static constexpr bool PERM = false, AFTER_DRAIN = false;
    const float* ssq3; float* S;
    __device__ __forceinline__ void operator()(const Acc& acc, const Unit& u, int wr, int wc, int fr, int fq, LAS unsigned char*) const {
        const int row0 = u.pm * BM + wr * 64 + fr, col0 = u.pn * BM + wc * 32 + 4 * fq;
#pragma unroll
        for (int ai = 0; ai < 2; ++ai)
#pragma unroll
            for (int m = 0; m < 4; ++m) { const int row = row0 + ai * HALF + m * 16; const float rs = row_rstd(ssq3, row, fq); float* rowp = S + (size_t)row * 2048 + col0;
#pragma unroll
                for (int bj = 0; bj < 2; ++bj)
#pragma unroll
                    for (int n = 0; n < 2; ++n) *(f32x4*)(rowp + bj * HALF + n * 16) = acc[ai][bj][m][n] * rs; }
    }
};
}

__device__ __forceinline__ void conv_trans_tile(const float* __restrict__ src, int ldsrc, int k0, int n0, h16* __restrict__ dst, int lddst, const float* __restrict__ rs, int rs_off, LAS unsigned char* lds) {
  LAS h16* tile = (LAS h16*)lds;
  const int tid = threadIdx.x;
  const int c4 = tid & 31, r = tid >> 5;
  f32x4 v[4];
#pragma unroll
  for (int p = 0; p < 4; ++p) v[p] = *(const f32x4*)(src + (size_t)(k0 + r + 16 * p) * ldsrc + n0 + c4 * 4);
  __syncthreads();
#pragma unroll
  for (int p = 0; p < 4; ++p) { const int k = r + 16 * p; float s = 1.0f; if (rs) { int kk = k0 + k + rs_off; s = kk >= 0 ? rs[kk] : 1.0f; }
#pragma unroll
    for (int j = 0; j < 4; ++j) tile[(c4 * 4 + j) * 72 + k] = (h16)(v[p][j] * s); }
  __syncthreads();
#pragma unroll
  for (int p = 0; p < 2; ++p) { const int n = (tid >> 3) + 64 * p, k8 = (tid & 7) * 8;
    const u32x4 w = *(const LAS u32x4*)(tile + n * 72 + k8);
    *(u32x4*)(dst + (size_t)(n0 + n) * lddst + k0 + k8) = w; }
}
__device__ __forceinline__ void conv_copy_rows(const float* __restrict__ src, int ldsrc, int r0, int rows, int cols, h16* __restrict__ dst, int lddst, const float* __restrict__ rs) {
  const int per_row = cols >> 3, total = rows * per_row;
  for (int i = threadIdx.x; i < total; i += NTHREADS) { const int r = r0 + i / per_row, c = (i % per_row) * 8;
    const float s = rs ? rs[r] : 1.0f;
    const f32x4 a = *(const f32x4*)(src + (size_t)r * ldsrc + c), b = *(const f32x4*)(src + (size_t)r * ldsrc + c + 4);
    u32x4 w; w.x = pk_h2(a[0] * s, a[1] * s); w.y = pk_h2(a[2] * s, a[3] * s); w.z = pk_h2(b[0] * s, b[1] * s); w.w = pk_h2(b[2] * s, b[3] * s);
    *(u32x4*)(dst + (size_t)r * lddst + c) = w; }
}
__device__ __forceinline__ void conv_rows_norm(const float* __restrict__ x, int row0, h16* __restrict__ x16, float* __restrict__ rstd_out, const float* __restrict__ g) {
  const int lane = threadIdx.x & 63, row = row0 + (threadIdx.x >> 6);
  const float* xr = x + (size_t)row * 2048; f32x4 a[4], b[4]; float ss = 0.f;
#pragma unroll
  for (int j = 0; j < 4; ++j) { a[j] = *(const f32x4*)(xr + (j * 64 + lane) * 8); b[j] = *(const f32x4*)(xr + (j * 64 + lane) * 8 + 4);
    ss += (a[j][0] * a[j][0] + a[j][1] * a[j][1]) + (a[j][2] * a[j][2] + a[j][3] * a[j][3]) + (b[j][0] * b[j][0] + b[j][1] * b[j][1]) + (b[j][2] * b[j][2] + b[j][3] * b[j][3]); }
  ss = wave_sum(ss);
  const float r = rsqrtf(ss * (1.0f / 2048.0f) + EPS_);
  if (rstd_out && lane == 0) rstd_out[row] = r;
#pragma unroll
  for (int j = 0; j < 4; ++j) { f32x4 p = a[j], q = b[j];
    if (g) { const f32x4 g0 = *(const f32x4*)(g + (j * 64 + lane) * 8), g1 = *(const f32x4*)(g + (j * 64 + lane) * 8 + 4); p = p * g0 * r; q = q * g1 * r; }
    u32x4 w; w.x = pk_h2(p[0], p[1]); w.y = pk_h2(p[2], p[3]); w.z = pk_h2(q[0], q[1]); w.w = pk_h2(q[2], q[3]);
    *(u32x4*)(x16 + (size_t)row * 2048 + (j * 64 + lane) * 8) = w; }
}
__device__ __forceinline__ void conv_table_rows(const float* __restrict__ tab, int row0, unsigned char* __restrict__ t8, float* __restrict__ sc) {
  const int lane = threadIdx.x & 63, row = row0 + (threadIdx.x >> 6);
  const float* xr = tab + (size_t)row * 2048; f32x4 a[4], b[4]; float mx = 0.f;
#pragma unroll
  for (int j = 0; j < 4; ++j) { a[j] = *(const f32x4*)(xr + (j * 64 + lane) * 8); b[j] = *(const f32x4*)(xr + (j * 64 + lane) * 8 + 4);
    mx = fmaxf(mx, fmaxf(fmaxf(fabsf(a[j][0]), fabsf(a[j][1])), fmaxf(fabsf(a[j][2]), fabsf(a[j][3]))));
    mx = fmaxf(mx, fmaxf(fmaxf(fabsf(b[j][0]), fabsf(b[j][1])), fmaxf(fabsf(b[j][2]), fabsf(b[j][3])))); }
  mx = wave_max(mx);
  const float s = mx > 0.f ? 400.0f / mx : 1.0f;
  if (lane == 0) sc[row] = mx > 0.f ? mx * (1.0f / 400.0f) : 1.0f;
#pragma unroll
  for (int j = 0; j < 4; ++j) { int w0 = __builtin_amdgcn_cvt_pk_fp8_f32(a[j][0] * s, a[j][1] * s, 0, false); w0 = __builtin_amdgcn_cvt_pk_fp8_f32(a[j][2] * s, a[j][3] * s, w0, true);
    int w1 = __builtin_amdgcn_cvt_pk_fp8_f32(b[j][0] * s, b[j][1] * s, 0, false); w1 = __builtin_amdgcn_cvt_pk_fp8_f32(b[j][2] * s, b[j][3] * s, w1, true);
    u32x2 w; w.x = (unsigned)w0; w.y = (unsigned)w1;
    *(u32x2*)(t8 + (size_t)row * 2048 + (j * 64 + lane) * 8) = w; }
}
__device__ __forceinline__ void sgu_pool_item(int nb, int q, const h16* __restrict__ U, const h16* __restrict__ V, const h16* __restrict__ Z, const f32x2* __restrict__ lnst,
                                              const float* __restrict__ ln_g, const float* __restrict__ ln_b, const h16* __restrict__ Wsgu, const float* __restrict__ sgu_b,
                                              h16* __restrict__ A2, LAS unsigned char* lds) {
  const int tid = threadIdx.x, lane = tid & 63, wid = tid >> 6;
  LAS h16* vt = (LAS h16*)lds;
  LAS f32x2* stat = (LAS f32x2*)(lds + 36864);
  const int t0 = nb * 128;
  __syncthreads();
  if (tid < 128) { const f32x2* p = lnst + (size_t)(t0 + tid) * 16; float s = 0.f, ss = 0.f;
#pragma unroll
    for (int i = 0; i < 16; ++i) { const f32x2 v = p[i]; s += v.x; ss += v.y; }
    const float mean = s * (1.0f / 1024.0f); const float var = fmaxf(ss * (1.0f / 1024.0f) - mean * mean, 0.f);
    stat[tid] = (f32x2){mean, rsqrtf(var + EPS_)}; }
  __syncthreads();
  for (int hh = 0; hh < 4; ++hh) {
    const int h = 4 * q + hh;
#pragma unroll
    for (int i = 0; i < 4; ++i) { const int ch = tid + NTHREADS * i; const int j = ch >> 4, d8 = (ch & 15) * 8;
      const half8 v = *(const half8*)(V + (size_t)(t0 + j) * 1024 + h * 128 + d8);
      const f32x2 st = stat[j];
      const f32x4 g0 = *(const f32x4*)(ln_g + h * 128 + d8), g1 = *(const f32x4*)(ln_g + h * 128 + d8 + 4), b0 = *(const f32x4*)(ln_b + h * 128 + d8), b1 = *(const f32x4*)(ln_b + h * 128 + d8 + 4);
#pragma unroll
      for (int e = 0; e < 8; ++e) { const float gg = e < 4 ? g0[e & 3] : g1[e & 3], bb = e < 4 ? b0[e & 3] : b1[e & 3];
        vt[(d8 + e) * 136 + j] = (h16)(((float)v[e] - st.x) * st.y * gg + bb); } }
    __syncthreads();
    f32x4 acc[8];
#pragma unroll
    for (int nt = 0; nt < 8; ++nt) acc[nt] = (f32x4){0.f, 0.f, 0.f, 0.f};
    const int i_row = 16 * wid + (lane & 15);
    const int ksteps = (wid < 4) ? 2 : 4;
    for (int kk = 0; kk < ksteps; ++kk) {
      const half8 wf = *(const half8*)(Wsgu + ((size_t)h * 128 + i_row) * 128 + kk * 32 + 8 * (lane >> 4));
#pragma unroll
      for (int nt = 0; nt < 8; ++nt) { const half8 vf = *(const LAS half8*)(vt + (16 * nt + (lane & 15)) * 136 + kk * 32 + 8 * (lane >> 4));
        acc[nt] = __builtin_amdgcn_mfma_f32_16x16x32_f16(vf, wf, acc[nt], 0, 0, 0); }
    }
    const float bias = sgu_b[h * 128 + i_row];
    const size_t tok = (size_t)(t0 + i_row);
#pragma unroll
    for (int nt = 0; nt < 8; ++nt) { const int d0 = 16 * nt + 4 * (lane >> 4);
      const half4 uu = *(const half4*)(U + tok * 1024 + h * 128 + d0);
      u32x2 w; w.x = pk_h2((float)uu[0] * (acc[nt][0] + bias), (float)uu[1] * (acc[nt][1] + bias)); w.y = pk_h2((float)uu[2] * (acc[nt][2] + bias), (float)uu[3] * (acc[nt][3] + bias));
      *(u32x2*)(A2 + tok * 2048 + h * 128 + d0) = w; }
    __syncthreads();
  }
  { const int cc = tid & 63, tr = tid >> 6; const int col = 512 * q + cc * 8; const int g = col >> 8, w = 2 << g;
    const int tfirst = t0 + tr * 16; const int pos0 = tfirst & (SEQ_ - 1);
    float sum[8];
#pragma unroll
    for (int e = 0; e < 8; ++e) sum[e] = 0.f;
    for (int s = 1; s < w; ++s) { if (pos0 - s >= 0) { const half8 z = *(const half8*)(Z + (size_t)(tfirst - s) * 1024 + col);
#pragma unroll
        for (int e = 0; e < 8; ++e) sum[e] += (float)z[e]; } }
    for (int i = 0; i < 16; ++i) { const int t = tfirst + i, pos = pos0 + i;
      const half8 z = *(const half8*)(Z + (size_t)t * 1024 + col);
#pragma unroll
      for (int e = 0; e < 8; ++e) sum[e] += (float)z[e];
      const int cnt = pos + 1 < w ? pos + 1 : w; const float inv = 1.0f / (float)cnt;
      u32x4 o; float y[8];
#pragma unroll
      for (int e = 0; e < 8; ++e) y[e] = sum[e] * inv - (float)z[e];
      o.x = pk_h2(y[0], y[1]); o.y = pk_h2(y[2], y[3]); o.z = pk_h2(y[4], y[5]); o.w = pk_h2(y[6], y[7]);
      *(u32x4*)(A2 + (size_t)t * 2048 + 1024 + col) = o;
      if (pos - w + 1 >= 0) { const half8 zo = *(const half8*)(Z + (size_t)(t - w + 1) * 1024 + col);
#pragma unroll
        for (int e = 0; e < 8; ++e) sum[e] -= (float)zo[e]; } }
  }
}
constexpr int P6_TS = 0, P6_TI = 32768, P6_IG = 40960, P6_GU = 73728, P6_GV = 106496;
__device__ __forceinline__ void peer_topk(const float* S, const float* SU, const float* SV, int tw0, LAS unsigned char* lds) {
  LAS float* ts = (LAS float*)(lds + P6_TS); LAS unsigned char* ti = lds + P6_TI; LAS int* ig = (LAS int*)(lds + P6_IG); LAS float* gu = (LAS float*)(lds + P6_GU); LAS float* gv = (LAS float*)(lds + P6_GV);
  const int tid = threadIdx.x;
  for (int r = 0; r < 2; ++r) {
    { const int tl = tid >> 4, l = tid & 15; const int t = tw0 + 32 * r + tl;
      const float* sp = S + (size_t)t * 2048 + l * 128;
      float v[16]; int ix[16];
#pragma unroll
      for (int k = 0; k < 16; ++k) { v[k] = -INFINITY; ix[k] = 0; }
      for (int j4 = 0; j4 < 32; ++j4) { const f32x4 x4 = *(const f32x4*)(sp + j4 * 4);
#pragma unroll
        for (int e = 0; e < 4; ++e) { float x = x4[e]; int xi = j4 * 4 + e;
#pragma unroll
          for (int k = 0; k < 16; ++k) { const bool gt = x > v[k]; const float tv = gt ? v[k] : x; const int tix = gt ? ix[k] : xi; v[k] = gt ? x : v[k]; ix[k] = gt ? xi : ix[k]; x = tv; xi = tix; } } }
      __syncthreads();
#pragma unroll
      for (int k = 0; k < 16; ++k) { ts[(tl * 16 + l) * 16 + k] = v[k]; ti[(tl * 16 + l) * 16 + k] = (unsigned char)ix[k]; }
    }
    __syncthreads();
    if (tid < 256) { const int tl = tid >> 3, h = tid & 7;
      LAS const float* pa = ts + (tl * 16 + 2 * h) * 16; LAS const float* pb = pa + 16;
      float a[16], b[16];
#pragma unroll
      for (int k = 0; k < 16; ++k) { a[k] = pa[k]; b[k] = pb[k]; }
      float bs[16]; int bc[16];
#pragma unroll
      for (int k = 0; k < 16; ++k) { bs[k] = -INFINITY; bc[k] = 0; }
#pragma unroll
      for (int i = 0; i < 16; ++i)
#pragma unroll
        for (int j = 0; j < 16; ++j) if ((i + 1) * (j + 1) <= 16) { float x = a[i] + b[j]; int xi = i * 16 + j;
#pragma unroll
          for (int k = 0; k < 16; ++k) { const bool gt = x > bs[k]; const float tv = gt ? bs[k] : x; const int tix = gt ? bc[k] : xi; bs[k] = gt ? x : bs[k]; bc[k] = gt ? xi : bc[k]; x = tv; xi = tix; } }
      float ex[16]; float sum = 0.f;
#pragma unroll
      for (int k = 0; k < 16; ++k) { ex[k] = __expf(bs[k] - bs[0]); sum += ex[k]; }
      const float inv = 1.0f / sum;
      LAS const unsigned char* ia = ti + (tl * 16 + 2 * h) * 16; LAS const unsigned char* ib = ia + 16;
#pragma unroll
      for (int k = 0; k < 16; ++k) { const int id = (int)ia[bc[k] >> 4] * 128 + (int)ib[bc[k] & 15]; const int o = (32 * r + tl) * 128 + h * 16 + k;
        ig[o] = id; gu[o] = SU[id]; gv[o] = ex[k] * inv * SV[id]; }
    }
  }
  __syncthreads();
}

struct RowBuf { u32x4 u0, u1, v0, v1; };
__device__ __forceinline__ void fp8x4_to_f32(unsigned w, float* o) { const f32x2 lo = __builtin_amdgcn_cvt_pk_f32_fp8((int)w, false), hi = __builtin_amdgcn_cvt_pk_f32_fp8((int)w, true); o[0] = lo.x; o[1] = lo.y; o[2] = hi.x; o[3] = hi.y; }

__device__ __forceinline__ void peer_gather_wave(float* h2, const unsigned char* U8, const unsigned char* V8, const float* __restrict__ g_peer, const float* __restrict__ g_final,
                                                 int t0, int tl0, int ntok, LAS unsigned char* lds) {
  LAS const int* ig = (LAS const int*)(lds + P6_IG); LAS const float* gu = (LAS const float*)(lds + P6_GU); LAS const float* gv = (LAS const float*)(lds + P6_GV);
  const int lane = threadIdx.x & 63;
  for (int it = 0; it < ntok; ++it) {
    const int t = t0 + it, tl = tl0 + it;
    asm volatile("" ::: "memory");
    float* hr = h2 + (size_t)t * 2048;
    float n[32], acc[32]; float ss = 0.f;
#pragma unroll
    for (int j = 0; j < 2; ++j)
#pragma unroll
      for (int q = 0; q < 4; ++q) { const f32x4 x = *(const f32x4*)(hr + (j * 64 + lane) * 16 + q * 4);
        n[j * 16 + q * 4 + 0] = x[0]; n[j * 16 + q * 4 + 1] = x[1]; n[j * 16 + q * 4 + 2] = x[2]; n[j * 16 + q * 4 + 3] = x[3];
        ss += (x[0] * x[0] + x[1] * x[1]) + (x[2] * x[2] + x[3] * x[3]); }
    ss = wave_sum(ss);
    const float r3 = rsqrtf(ss * (1.0f / 2048.0f) + EPS_);
#pragma unroll
    for (int j = 0; j < 2; ++j)
#pragma unroll
      for (int q = 0; q < 4; ++q) { const f32x4 g = *(const f32x4*)(g_peer + (j * 64 + lane) * 16 + q * 4);
#pragma unroll
        for (int e = 0; e < 4; ++e) { n[j * 16 + q * 4 + e] *= r3 * g[e]; acc[j * 16 + q * 4 + e] = 0.f; } }
    LAS const int* igt = ig + tl * 128; LAS const float* gut = gu + tl * 128; LAS const float* gvt = gv + tl * 128;
#define P6_LOAD(B, E) do { const int _id = __builtin_amdgcn_readfirstlane(igt[(E) < 128 ? (E) : 127]); const unsigned char* _up = U8 + (size_t)_id * 2048 + lane * 16; const unsigned char* _vp = V8 + (size_t)_id * 2048 + lane * 16; \
      B.u0 = *(const u32x4*)_up; B.u1 = *(const u32x4*)(_up + 1024); B.v0 = *(const u32x4*)_vp; B.v1 = *(const u32x4*)(_vp + 1024); } while (0)
#define P6_PROC(B, E) do { float dot = 0.f; float f[4]; \
      _Pragma("unroll") for (int q = 0; q < 4; ++q) { fp8x4_to_f32(B.u0[q], f); dot += (f[0] * n[q * 4 + 0] + f[1] * n[q * 4 + 1]) + (f[2] * n[q * 4 + 2] + f[3] * n[q * 4 + 3]); } \
      _Pragma("unroll") for (int q = 0; q < 4; ++q) { fp8x4_to_f32(B.u1[q], f); dot += (f[0] * n[16 + q * 4 + 0] + f[1] * n[16 + q * 4 + 1]) + (f[2] * n[16 + q * 4 + 2] + f[3] * n[16 + q * 4 + 3]); } \
      dot = wave_sum(dot) * gut[E]; const float a = gelu_f(dot) * gvt[E]; \
      _Pragma("unroll") for (int q = 0; q < 4; ++q) { fp8x4_to_f32(B.v0[q], f); acc[q * 4 + 0] += a * f[0]; acc[q * 4 + 1] += a * f[1]; acc[q * 4 + 2] += a * f[2]; acc[q * 4 + 3] += a * f[3]; } \
      _Pragma("unroll") for (int q = 0; q < 4; ++q) { fp8x4_to_f32(B.v1[q], f); acc[16 + q * 4 + 0] += a * f[0]; acc[16 + q * 4 + 1] += a * f[1]; acc[16 + q * 4 + 2] += a * f[2]; acc[16 + q * 4 + 3] += a * f[3]; } } while (0)
    RowBuf b0, b1, b2, b3;
    P6_LOAD(b0, 0); P6_LOAD(b1, 1); P6_LOAD(b2, 2); P6_LOAD(b3, 3);
    for (int e = 0; e < 128; e += 4) {
      P6_PROC(b0, e);     P6_LOAD(b0, e + 4);
      P6_PROC(b1, e + 1); P6_LOAD(b1, e + 5);
      P6_PROC(b2, e + 2); P6_LOAD(b2, e + 6);
      P6_PROC(b3, e + 3); P6_LOAD(b3, e + 7);
    }
#undef P6_LOAD
#undef P6_PROC
    asm volatile("" ::: "memory");
    float s2 = 0.f;
#pragma unroll
    for (int j = 0; j < 2; ++j)
#pragma unroll
      for (int q = 0; q < 4; ++q) { const f32x4 x = *(const f32x4*)(hr + (j * 64 + lane) * 16 + q * 4);
#pragma unroll
        for (int e = 0; e < 4; ++e) { const float hh = x[e] + acc[j * 16 + q * 4 + e]; acc[j * 16 + q * 4 + e] = hh; s2 += hh * hh; } }
    s2 = wave_sum(s2);
    const float rf = rsqrtf(s2 * (1.0f / 2048.0f) + EPS_);
#pragma unroll
    for (int j = 0; j < 2; ++j)
#pragma unroll
      for (int q = 0; q < 4; ++q) { const f32x4 g = *(const f32x4*)(g_final + (j * 64 + lane) * 16 + q * 4); f32x4 o;
#pragma unroll
        for (int e = 0; e < 4; ++e) o[e] = acc[j * 16 + q * 4 + e] * rf * g[e];
        *(f32x4*)(hr + (j * 64 + lane) * 16 + q * 4) = o; }
  }
}
struct Args { const float* in[22]; float* out; unsigned char* ws; int ph_lo, ph_hi; };

__device__ __forceinline__ void p0a_chunk(int id, const Args& a, LAS unsigned char* lds) {
  unsigned char* ws = a.ws;
  const float* mem = a.in[1]; const float* g_mix = a.in[2]; const float* w_in = a.in[3]; const float* pool_w = a.in[8]; const float* g_mem = a.in[12]; const float* w_kv = a.in[14];
  const float* g_peer = a.in[16]; const float* w_query = a.in[17]; const float* sub_keys = a.in[18];
  if (id < 1024) { conv_trans_tile(w_kv, 4096, (id >> 5) * 64, (id & 31) * 128, (h16*)(ws + O_WKVT), 2048, nullptr, 0, lds); return; }
  id -= 1024;
  if (id < 64) { conv_rows_norm(mem, id * 8, (h16*)(ws + O_M16), nullptr, g_mem); return; }
  id -= 64;
  if (id < 128) { conv_copy_rows(w_in + 2048, 3072, id * 16, 16, 1024, (h16*)(ws + O_WINZ), 1024, g_mix); return; }
  id -= 128;
  if (id < 32) { const int g = id >> 3, t = id & 7; conv_trans_tile(pool_w + (size_t)g * 65536, 256, (t >> 1) * 64, (t & 1) * 128, (h16*)(ws + O_WPOOLT) + (size_t)g * 65536, 256, nullptr, 0, lds); return; }
  id -= 32;
  if (id < 256) { conv_copy_rows(w_query, 2048, id * 8, 8, 2048, (h16*)(ws + O_WQRY), 2048, g_peer); return; }
  id -= 256;
  { h16* dst = (h16*)(ws + O_SKBD);
    for (int i = threadIdx.x; i < 2048; i += NTHREADS) { const int e0 = id * 16384 + i * 8; const int h = e0 >> 16, r = (e0 >> 8) & 255, c = e0 & 255; const int p = r >> 7, key = r & 127, pp = c >> 7, cc = c & 127;
      u32x4 w = (u32x4){0u, 0u, 0u, 0u};
      if (p == pp) { const float* s = sub_keys + ((size_t)((h * 2 + p) * 128 + key)) * 128 + cc; const f32x4 x = *(const f32x4*)s, y = *(const f32x4*)(s + 4);
        w.x = pk_h2(x[0], x[1]); w.y = pk_h2(x[2], x[3]); w.z = pk_h2(y[0], y[1]); w.w = pk_h2(y[2], y[3]); }
      *(u32x4*)(dst + e0) = w; } }
}
constexpr int P0A_CHUNKS = 1024 + 64 + 128 + 32 + 256 + 32;

__device__ __forceinline__ void p0b_chunk(int id, const Args& a, LAS unsigned char* lds) {
  unsigned char* ws = a.ws;
  const float* x = a.in[0]; const float* g_mix = a.in[2]; const float* w_in = a.in[3]; const float* sgu_w = a.in[6]; const float* pool_scale = a.in[9]; const float* w_out = a.in[10];
  const float* g_xattn = a.in[11]; const float* w_q = a.in[13]; const float* w_o = a.in[15]; const float* peer_u = a.in[19]; const float* peer_v = a.in[20];
  if (id < 2048) { conv_rows_norm(x, id * 8, (h16*)(ws + O_RA), (float*)(ws + O_RSTD1), nullptr); return; }
  id -= 2048;
  if (id < 512) { conv_trans_tile(w_in, 3072, (id >> 4) * 64, (id & 15) * 128, (h16*)(ws + O_W1T), 2048, g_mix, 0, lds); return; }
  id -= 512;
  if (id < 512) { conv_trans_tile(w_out, 2048, (id >> 4) * 64, (id & 15) * 128, (h16*)(ws + O_W3T), 2048, pool_scale, -1024, lds); return; }
  id -= 512;
  if (id < 512) { conv_trans_tile(w_o, 2048, (id >> 4) * 64, (id & 15) * 128, (h16*)(ws + O_WOT), 2048, nullptr, 0, lds); return; }
  id -= 512;
  if (id < 256) { conv_copy_rows(w_q, 2048, id * 8, 8, 2048, (h16*)(ws + O_WQ16), 2048, g_xattn); return; }
  id -= 256;
  if (id < 8) { h16* dst = (h16*)(ws + O_WSGU);
    for (int i = threadIdx.x; i < 2048; i += NTHREADS) { const int e0 = id * 16384 + i * 8; const int ii = (e0 >> 7) & 127, j = e0 & 127;
      u32x4 w = (u32x4){0u, 0u, 0u, 0u};
      if ((j >> 6) <= (ii >> 6)) { const f32x4 p = *(const f32x4*)(sgu_w + e0), q = *(const f32x4*)(sgu_w + e0 + 4); w.x = pk_h2(p[0], p[1]); w.y = pk_h2(p[2], p[3]); w.z = pk_h2(q[0], q[1]); w.w = pk_h2(q[2], q[3]); }
      *(u32x4*)(dst + e0) = w; }
    return; }
  id -= 8;
  if (id < 2048) { conv_table_rows(peer_u, id * 8, ws + O_U8, (float*)(ws + O_SU)); return; }
  id -= 2048;
  conv_table_rows(peer_v, id * 8, ws + O_V8, (float*)(ws + O_SV));
}
constexpr int P0B_CHUNKS = 2048 + 512 * 3 + 256 + 8 + 4096;

#define XB_TMO      128
#define XB_XCNT(j)  (256  + 64 * (j))
#define XB_XSUB(j)  (1280 + 64 * (j))
#define XB_XGEN(j)  (2304 + 64 * (j))
#define XB_TOP      3328
#define XB_TOPGEN   3392
#define XCD_BAR_WORDS 3456
#define XB_SPIN_CAP (1u << 20)
__device__ __forceinline__ unsigned xb_ld(unsigned* p)              { return __hip_atomic_load(p, __ATOMIC_RELAXED, __HIP_MEMORY_SCOPE_AGENT); }
__device__ __forceinline__ unsigned xb_add(unsigned* p, unsigned v) { return __hip_atomic_fetch_add(p, v, __ATOMIC_RELAXED, __HIP_MEMORY_SCOPE_AGENT); }
__device__ __forceinline__ unsigned xb_xcc_id() { return (unsigned)__builtin_amdgcn_s_getreg((3 << 11) | 20) & 0xFu; }
#define XB_SPIN(cond, bar) do { unsigned _sp = 0; while (cond) { __builtin_amdgcn_s_sleep(1); \
    if ((++_sp & 255u) == 0u) { if (xb_ld(&(bar)[XB_TMO])) break; if (_sp > XB_SPIN_CAP) { atomicAdd(&(bar)[XB_TMO], 1u); break; } } } } while (0)
struct XcdBarrier { unsigned* bar; unsigned x; volatile LAS unsigned* st; };
__device__ __forceinline__ XcdBarrier xcd_barrier_post(unsigned* bar, volatile LAS unsigned* st) {
  XcdBarrier b; b.bar = bar; b.x = xb_xcc_id(); b.st = st;
  if (threadIdx.x == 0) (void)xb_add(&bar[XB_XCNT(b.x)], 1u);
  return b;
}
__device__ __forceinline__ void xcd_barrier_complete(unsigned* bar, unsigned x, unsigned& nloc, unsigned& nx) {
  const unsigned G = gridDim.x; unsigned sum, cnt, mine, sp = 0u;
  for (;;) { sum = 0u; cnt = 0u; mine = 0u;
#pragma unroll
    for (unsigned j = 0; j < 16; ++j) { const unsigned c = xb_ld(&bar[XB_XCNT(j)]); sum += c; cnt += (c > 0u) ? 1u : 0u; mine = (j == x) ? c : mine; }
    if (sum == G) break;
    __builtin_amdgcn_s_sleep(1);
    if ((++sp & 255u) == 0u) { if (xb_ld(&bar[XB_TMO])) break; if (sp > XB_SPIN_CAP) { atomicAdd(&bar[XB_TMO], 1u); break; } } }
  nloc = mine > 0u ? mine : 1u; nx = cnt > 0u ? cnt : 1u;
}
__device__ __forceinline__ void xcd_barrier(const XcdBarrier& b) {
  asm volatile("s_waitcnt vmcnt(0)" ::: "memory");
  __syncthreads();
  if (threadIdx.x == 0) {
    unsigned* bar = b.bar;
    __builtin_amdgcn_s_waitcnt(0);
    unsigned nloc = b.st[0], nx = b.st[1];
    if (nloc == 0u) { xcd_barrier_complete(bar, b.x, nloc, nx); b.st[0] = nloc; b.st[1] = nx; }
    const unsigned old = xb_add(&bar[XB_XSUB(b.x)], 1u);
    const unsigned gen = old / nloc;
    if (old + 1u == (gen + 1u) * nloc) {
      __builtin_amdgcn_fence(__ATOMIC_RELEASE, "agent");
      asm volatile("s_waitcnt vmcnt(0)" ::: "memory");
      const unsigned og = xb_add(&bar[XB_TOP], 1u);
      const unsigned tg = og / nx;
      if (og + 1u == (tg + 1u) * nx) xb_add(&bar[XB_TOPGEN], 1u);
      else XB_SPIN(xb_ld(&bar[XB_TOPGEN]) == tg, bar);
      __builtin_amdgcn_fence(__ATOMIC_ACQUIRE, "agent");
      xb_add(&bar[XB_XGEN(b.x)], 1u);
      asm volatile("s_waitcnt vmcnt(0)" ::: "memory");
    } else {
      XB_SPIN(xb_ld(&bar[XB_XGEN(b.x)]) == gen, bar);
      __builtin_amdgcn_fence(__ATOMIC_ACQUIRE, "agent");
      asm volatile("s_waitcnt vmcnt(0)" ::: "memory");
    }
  }
  __syncthreads();
}

constexpr int NPHASE = 9;
constexpr int CW_QUEUE = 0;
constexpr int CW_BAR = 1024;

__global__ void __launch_bounds__(NTHREADS, 2) fwd_kernel(Args a) {
  extern __shared__ __attribute__((aligned(16))) unsigned char lds_raw[];
  LAS unsigned char* lds = (LAS unsigned char*)lds_raw;
  const int tid = threadIdx.x, c = blockIdx.x, G = gridDim.x;
  unsigned char* ws = a.ws; unsigned* ctl = (unsigned*)(ws + O_CTL);
  volatile LAS unsigned* misc = (volatile LAS unsigned*)(lds + LDS_BYTES - 64);
  if (tid < 16) misc[tid] = 0u;
  __syncthreads();
  const bool multi = (a.ph_hi - a.ph_lo) > 1;
  XcdBarrier bar; bar.bar = ctl + CW_BAR; bar.x = 0; bar.st = misc + 8;
  if (multi) bar = xcd_barrier_post(ctl + CW_BAR, misc + 8);
#define IN(k) (a.ph_lo <= (k) && (k) < a.ph_hi)
#define SEAM(k) do { if (IN(k) && IN((k) + 1)) xcd_barrier(bar); } while (0)
  const long NOB = 1L << 30;
  if (IN(0)) { for (int id = c; id < P0A_CHUNKS; id += G) p0a_chunk(id, a, lds); }
  SEAM(0);
  if (IN(1)) {
    if (c < 32) { pg::Gemm g{(const h16*)(ws + O_M16), (const h16*)(ws + O_WKVT), 2048, 2048, 2048, (int)NOB, 0}; pg::OneUnit S{{c >> 4, c & 15}}; pg::EpiHalf E{(h16*)(ws + O_KV16), 4096};
      pg::gemm_phase(lds, g, S, E); }
    else if (c < 64) { const int z = (c - 32) >> 3, pn = (c - 32) & 7;
      pg::Gemm g{(const h16*)(ws + O_WPOOLT) + (size_t)z * 65536, (const h16*)(ws + O_WINZ) + z * 256, 256, 1024, 256, (int)NOB, 0}; pg::OneUnit S{{0, pn}};
      pg::EpiHalf E{(h16*)(ws + O_W1T) + (size_t)(2048 + z * 256) * 2048, 2048}; pg::gemm_phase(lds, g, S, E); }
    else if (c < 128) { const int z = (c - 64) >> 3, pn = (c - 64) & 7;
      pg::Gemm g{(const h16*)(ws + O_SKBD) + (size_t)z * 65536, (const h16*)(ws + O_WQRY) + z * 256, 256, 2048, 256, (int)NOB, 0}; pg::OneUnit S{{0, pn}};
      pg::EpiHalf E{(h16*)(ws + O_WQST) + (size_t)z * 256 * 2048, 2048}; pg::gemm_phase(lds, g, S, E); }
    for (;;) { __syncthreads(); if (tid == 0) misc[0] = atomicAdd(ctl + CW_QUEUE, 1u); __syncthreads(); const int id = (int)misc[0]; if (id >= P0B_CHUNKS) break; p0b_chunk(id, a, lds); }
  }
  SEAM(1);
  if (IN(2)) { pg::Gemm g{(const h16*)(ws + O_RA), (const h16*)(ws + O_W1T), 2048, 2048, 2048, (int)NOB, 0}; pg::StaticOrder S; S.init(64, 12, G, c);
    pg::Epi1 E{(const float*)(ws + O_RSTD1), (h16*)(ws + O_RB), (f32x2*)(ws + O_LNST)};
    pg::gemm_phase(lds, g, S, E); }
  SEAM(2);
  if (IN(3)) {
    if (c < 64) { const int z = c >> 3, pn = c & 7, b = z >> 2, h = z & 3;
      pg::Gemm g{(const h16*)(ws + O_KV16) + (size_t)(b * 256) * 4096 + h * 512, (const h16*)(ws + O_WQ16) + h * 512, 4096, 2048, 512, (int)NOB, 0}; pg::OneUnit S{{0, pn}};
      pg::EpiHalf E{(h16*)(ws + O_WQKT) + (size_t)(b * 1024 + h * 256) * 2048, 2048}; pg::gemm_phase(lds, g, S, E); }
    else if (c < 128) { const int z = (c - 64) >> 3, pm = (c - 64) & 7, b = z >> 2, h = z & 3;
      pg::Gemm g{(const h16*)(ws + O_WOT) + h * 512, (const h16*)(ws + O_KV16) + (size_t)(b * 256) * 4096 + 2048 + h * 512, 2048, 4096, 512, (int)NOB, 0}; pg::OneUnit S{{pm, 0}};
      pg::EpiHalf E{(h16*)(ws + O_WVOT) + (size_t)b * 2048 * 1024 + h * 256, 1024}; pg::gemm_phase(lds, g, S, E); }
    for (int it = c; it < 256; it += G)
      sgu_pool_item(it >> 1, it & 1, (const h16*)(ws + O_RB), (const h16*)(ws + O_RB + 32 * MiB), (const h16*)(ws + O_RB + 64 * MiB), (const f32x2*)(ws + O_LNST), a.in[4], a.in[5],
                    (const h16*)(ws + O_WSGU), a.in[7], (h16*)(ws + O_RA), lds);
  }
  SEAM(3);
  if (IN(4)) { pg::Gemm g{(const h16*)(ws + O_RA), (const h16*)(ws + O_W3T), 2048, 2048, 2048, (int)NOB, 0}; pg::StaticOrder S; S.init(64, 8, G, c);
    pg::EpiRes E{a.in[0], a.out, (h16*)(ws + O_RB), (float*)(ws + O_SSQ2)}; pg::gemm_phase(lds, g, S, E); }
  SEAM(4);
  if (IN(5)) { pg::Gemm g{(const h16*)(ws + O_RB), (const h16*)(ws + O_WQKT), 2048, 2048, 2048, 32, (long)1024 * 2048}; pg::StaticOrder S; S.init(64, 4, G, c);
    pg::EpiSoftmax E{(const float*)(ws + O_SSQ2), (h16*)(ws + O_RB + 64 * MiB)}; pg::gemm_phase(lds, g, S, E); }
  SEAM(5);
  if (IN(6)) { pg::Gemm g{(const h16*)(ws + O_RB + 64 * MiB), (const h16*)(ws + O_WVOT), 1024, 1024, 1024, 32, (long)2048 * 1024}; pg::StaticOrder S; S.init(64, 8, G, c);
    pg::EpiRes E{a.out, a.out, (h16*)(ws + O_RA), (float*)(ws + O_SSQ3)}; pg::gemm_phase(lds, g, S, E); }
  SEAM(6);
  if (IN(7)) { pg::Gemm g{(const h16*)(ws + O_RA), (const h16*)(ws + O_WQST), 2048, 2048, 2048, (int)NOB, 0}; pg::StaticOrder S; S.init(64, 8, G, c);
    pg::EpiScore E{(const float*)(ws + O_SSQ3), (float*)(ws + O_RB)}; pg::gemm_phase(lds, g, S, E); }
  SEAM(7);
  if (IN(8)) {
    peer_topk((const float*)(ws + O_RB), (const float*)(ws + O_SU), (const float*)(ws + O_SV), 64 * c, lds);
    const int wid = tid >> 6;
    peer_gather_wave(a.out, ws + O_U8, ws + O_V8, a.in[16], a.in[21], 64 * c + 8 * wid, 8 * wid, 8, lds);
  }
#undef IN
#undef SEAM
}
#ifndef HYBRID_CUT
#define HYBRID_CUT 9
#endif
#ifndef ONE_LAUNCH
#define ONE_LAUNCH 0
#endif

#if HYBRID_CUT < 9
static void slow_xattn(hipStream_t stream, void* const* d_in, float* h, float* ws) {
  const float* mem = (const float*)d_in[1]; const float* g_xattn = (const float*)d_in[11]; const float* g_mem = (const float*)d_in[12]; const float* w_q = (const float*)d_in[13]; const float* w_kv = (const float*)d_in[14]; const float* w_o = (const float*)d_in[15];
  float* R0 = ws; float* R1 = R0 + (size_t)TT * 3072; float* S0 = R1 + (size_t)TT * 2048; float* mnorm = S0; float* kv = S0 + (size_t)512 * 2048;
  hipLaunchKernelGGL(k_rmsnorm, dim3(TT), dim3(256), 0, stream, (const float*)h, g_xattn, R1);
  hipLaunchKernelGGL(k_rmsnorm, dim3(512), dim3(256), 0, stream, mem, g_mem, mnorm);
  gemm(stream, mnorm, 2048, w_kv, 4096, 0, kv, 4096, nullptr, 512, 4096, 2048);
  float* q = R0; float* sc = R0 + (size_t)TT * 2048;
  gemm(stream, R1, 2048, w_q, 2048, 0, q, 2048, nullptr, TT, 2048, 2048);
  gemm(stream, q, 2048, kv, 4096, 1, sc, 256, nullptr, SEQ, 256, 512, 8, 4, (long)SEQ * 2048, 512, (long)256 * 4096, 512, (long)4 * SEQ * 256, (long)SEQ * 256);
  hipLaunchKernelGGL(k_softmax256, dim3(8 * SEQ / 4), dim3(256), 0, stream, sc, 0.044194173824159216f);
  gemm(stream, sc, 256, kv + 2048, 4096, 0, R1, 2048, nullptr, SEQ, 512, 256, 8, 4, (long)4 * SEQ * 256, (long)SEQ * 256, (long)256 * 4096, 512, (long)SEQ * 2048, 512);
  gemm(stream, R1, 2048, w_o, 2048, 0, h, 2048, h, TT, 2048, 2048);
}
static void slow_peer(hipStream_t stream, void* const* d_in, float* h, float* ws, float* out) {
  const float* g_peer = (const float*)d_in[16]; const float* w_query = (const float*)d_in[17]; const float* sub_keys = (const float*)d_in[18]; const float* peer_u = (const float*)d_in[19]; const float* peer_v = (const float*)d_in[20]; const float* g_final = (const float*)d_in[21];
  float* R0 = ws; float* R1 = R0 + (size_t)TT * 3072; float* S0 = R1 + (size_t)TT * 2048;
  int* idx = (int*)(S0 + (size_t)TT * 1024); float* gates = S0 + (size_t)TT * 1024 + (size_t)TT * 128;
  hipLaunchKernelGGL(k_rmsnorm, dim3(TT), dim3(256), 0, stream, (const float*)h, g_peer, R1);
  float* pq = R0; float* pscore = R1;
  gemm(stream, R1, 2048, w_query, 2048, 0, pq, 2048, nullptr, TT, 2048, 2048);
  gemm(stream, pq, 2048, sub_keys, 128, 1, pscore, 2048, nullptr, TT, 128, 128, 16, 1, 128, 0, 16384, 0, 128, 0);
  hipLaunchKernelGGL(k_topk, dim3(TT * 8 / 4), dim3(256), 0, stream, (const float*)pscore, idx, gates);
  hipLaunchKernelGGL(k_experts, dim3(TT / 4), dim3(256), 0, stream, g_peer, (const float*)h, (const int*)idx, (const float*)gates, peer_u, peer_v, g_final, out);
}
#endif

extern "C" void kernel_launch(void* const* d_in, const int* in_sizes, int n_in, void* d_out, int out_size, void* d_ws, size_t ws_size, hipStream_t stream) {
  static int grid = 0;
  if (grid == 0) {
    if (n_in != 22 || out_size != T_ * D_ || ws_size < WS_END) { fprintf(stderr, "kernel_launch: unexpected problem shape (n_in %d out %d ws %zu need %zu)\n", n_in, out_size, ws_size, (size_t)WS_END); grid = -1; return; }
    int dev = 0, cus = 0, per_cu = 0;
    (void)hipGetDevice(&dev); (void)hipDeviceGetAttribute(&cus, hipDeviceAttributeMultiprocessorCount, dev);
    if (hipFuncSetAttribute((const void*)fwd_kernel, hipFuncAttributeMaxDynamicSharedMemorySize, LDS_BYTES) != hipSuccess) { fprintf(stderr, "kernel_launch: hipFuncSetAttribute failed\n"); grid = -1; return; }
    (void)hipOccupancyMaxActiveBlocksPerMultiprocessor(&per_cu, (const void*)fwd_kernel, NTHREADS, LDS_BYTES);
    (void)hipGetLastError();
    if (cus != 256 || per_cu < 1) { fprintf(stderr, "kernel_launch: needs a 256-CU device with one resident workgroup per CU (cus %d, per_cu %d)\n", cus, per_cu); grid = -1; return; }
    grid = 256;
  }
  if (grid < 0) return;
  (void)hipMemsetAsync((char*)d_ws + O_CTL, 0, CTL_BYTES, stream);
  Args a{};
  for (int i = 0; i < 22; ++i) a.in[i] = (const float*)d_in[i];
  a.out = (float*)d_out; a.ws = (unsigned char*)d_ws;
#if ONE_LAUNCH
  a.ph_lo = 0; a.ph_hi = HYBRID_CUT;
  hipLaunchKernelGGL(fwd_kernel, dim3(grid), dim3(NTHREADS), LDS_BYTES, stream, a);
#else
  for (int p = 0; p < HYBRID_CUT; ++p) { a.ph_lo = p; a.ph_hi = p + 1; hipLaunchKernelGGL(fwd_kernel, dim3(grid), dim3(NTHREADS), LDS_BYTES, stream, a); }
#endif
#if HYBRID_CUT < 9
  float* h = (float*)d_out;
  if (HYBRID_CUT <= 5) slow_xattn(stream, d_in, h, (float*)d_ws);
  slow_peer(stream, d_in, h, (float*)d_ws, (float*)d_out);
#endif
}
```

```cpp
#define HYBRID_CUT 9
#define ONE_LAUNCH 1
#include <hip/hip_runtime.h>
#include <cstdio>
#include <math.h>

#define LAS __attribute__((address_space(3)))
typedef _Float16 h16;
typedef _Float16 half8 __attribute__((ext_vector_type(8)));
typedef _Float16 half4 __attribute__((ext_vector_type(4)));
typedef _Float16 half2v __attribute__((ext_vector_type(2)));
typedef float f32x4 __attribute__((ext_vector_type(4)));
typedef float f32x2 __attribute__((ext_vector_type(2)));
typedef unsigned u32x4 __attribute__((ext_vector_type(4)));
typedef unsigned u32x2 __attribute__((ext_vector_type(2)));

constexpr int T_ = 16384, D_ = 2048, SEQ_ = 8192;
constexpr float EPS_ = 1e-6f;
constexpr size_t MiB = 1ull << 20;
constexpr size_t O_W1T   = 0;
constexpr size_t O_W3T   = O_W1T   + 12 * MiB;
constexpr size_t O_WKVT  = O_W3T   + 8 * MiB;
constexpr size_t O_WQ16  = O_WKVT  + 16 * MiB;
constexpr size_t O_WOT   = O_WQ16  + 8 * MiB;
constexpr size_t O_WQRY  = O_WOT   + 8 * MiB;
constexpr size_t O_WQST  = O_WQRY  + 8 * MiB;
constexpr size_t O_WQKT  = O_WQST  + 8 * MiB;
constexpr size_t O_WVOT  = O_WQKT  + 8 * MiB;
constexpr size_t O_WINZ  = O_WVOT  + 8 * MiB;
constexpr size_t O_WPOOLT= O_WINZ  + 4 * MiB;
constexpr size_t O_SKBD  = O_WPOOLT+ 1 * MiB;
constexpr size_t O_WSGU  = O_SKBD  + 1 * MiB;
constexpr size_t O_M16   = O_WSGU  + 1 * MiB;
constexpr size_t O_KV16  = O_M16   + 2 * MiB;
constexpr size_t O_U8    = O_KV16  + 4 * MiB;
constexpr size_t O_V8    = O_U8    + 32 * MiB;
constexpr size_t O_SU    = O_V8    + 32 * MiB;
constexpr size_t O_SV    = O_SU    + 1 * MiB;
constexpr size_t O_RSTD1 = O_SV    + 1 * MiB;
constexpr size_t O_LNST  = O_RSTD1 + 1 * MiB;
constexpr size_t O_SSQ2  = O_LNST  + 2 * MiB;
constexpr size_t O_SSQ3  = O_SSQ2  + 2 * MiB;
constexpr size_t O_CTL   = O_SSQ3  + 2 * MiB;
constexpr size_t O_RA    = O_CTL   + 1 * MiB;
constexpr size_t O_RB    = O_RA    + 64 * MiB;
constexpr size_t WS_END  = O_RB    + 128 * MiB;
constexpr size_t CTL_BYTES = 64 * 1024;

constexpr int LDS_BYTES = 144 * 1024;
constexpr int NTHREADS = 512;

__device__ __forceinline__ float wave_sum(float v) {
  v += __builtin_bit_cast(float, __builtin_amdgcn_update_dpp(0, __builtin_bit_cast(int, v), 0xB1, 0xf, 0xf, true));
  v += __builtin_bit_cast(float, __builtin_amdgcn_update_dpp(0, __builtin_bit_cast(int, v), 0x4E, 0xf, 0xf, true));
  v += __builtin_bit_cast(float, __builtin_amdgcn_update_dpp(0, __builtin_bit_cast(int, v), 0x141, 0xf, 0xf, true));
  v += __builtin_bit_cast(float, __builtin_amdgcn_update_dpp(0, __builtin_bit_cast(int, v), 0x140, 0xf, 0xf, true));
  v += __builtin_bit_cast(float, __builtin_amdgcn_update_dpp(0, __builtin_bit_cast(int, v), 0x142, 0xa, 0xf, false));
  v += __builtin_bit_cast(float, __builtin_amdgcn_update_dpp(0, __builtin_bit_cast(int, v), 0x143, 0xc, 0xf, false));
  return __builtin_bit_cast(float, __builtin_amdgcn_readlane(__builtin_bit_cast(int, v), 63));
}
__device__ __forceinline__ float wave_max(float v) {
  for (int o = 32; o >= 1; o >>= 1) v = fmaxf(v, __shfl_xor(v, o));
  return v;
}
__device__ __forceinline__ unsigned pk_h2(float lo, float hi) { half2v r; r.x = (h16)lo; r.y = (h16)hi; return __builtin_bit_cast(unsigned, r); }
__device__ __forceinline__ float gelu_f(float v) { return 0.5f * v * (1.0f + erff(v * 0.70710678118654752f)); }
__device__ __forceinline__ f32x2 gelu_pk(f32x2 v) {
    const f32x2 av = __builtin_elementwise_abs(v), d = av * 0.2316418882f + 1.0f;
    f32x2 t; t.x = __builtin_amdgcn_rcpf(d.x); t.y = __builtin_amdgcn_rcpf(d.y);
    f32x2 q = t * 0.5307027145f + (-0.7265760135f); q = q * t + 0.7107068705f; q = q * t + (-0.142248368f); q = q * t + 0.127414796f; q = q * t;
    const f32x2 s = (v * v) * (-0.72134752044f);
    f32x2 e; e.x = __builtin_amdgcn_exp2f(s.x); e.y = __builtin_amdgcn_exp2f(s.y);
    const f32x2 m = v * (q * e), r = v - m;
    f32x2 o; o.x = v.x < 0.f ? m.x : r.x; o.y = v.y < 0.f ? m.y : r.y; return o;
}
namespace pg {
constexpr int BM = 256, BK = 64, HALF = 128, HTB = HALF * BK * 2, STAGE_BYTES = 8 * HTB, NXCD = 8, WGM = 8;

__host__ __device__ __forceinline__ int lds_byte(int r, int c) { const int st = (r >> 4) * 2 + (c >> 5), rr = r & 15, cc = c & 31, ob = rr * 64 + cc * 2; return st * 1024 + (ob ^ (((ob >> 9) & 1) << 5)); }
__host__ __device__ __forceinline__ void stage_rc(int b, int& R, int& C) { const int st = b / 1024, sb = b % 1024, swz = sb ^ (((sb >> 9) & 1) << 5); R = (st >> 1) * 16 + swz / 64; C = (st & 1) * 32 + (swz % 64) / 2; }
__host__ __device__ __forceinline__ int perm32(int rho) { const int n = rho >> 4, i = rho & 15; return 8 * (i >> 2) + 4 * n + (i & 3); }

struct Unit { int pm, pn; };
struct Gemm { const h16* A; const h16* Bt; int lda, ldb, K, bdiv; long bstride; };

struct StaticOrder {
    int nM, nN, nwg, G, c;
    __device__ void init(int nM_, int nN_, int G_, int c_) { nM = nM_; nN = nN_; nwg = nM * nN; G = G_; c = c_; }
    __device__ bool next(int i, Unit& u) const {
        const long L = (long)i * G + c; if (L >= nwg) return false;
        int wgid = (int)L; { const int q = nwg / NXCD, r = nwg % NXCD, xcd = wgid % NXCD, off = wgid / NXCD; wgid = (xcd < r ? xcd * (q + 1) : r * (q + 1) + (xcd - r) * q) + off; }
        const int nig = WGM * nN, gid = wgid / nig, fm = gid * WGM, gsz = (nM - fm) < WGM ? (nM - fm) : WGM;
        u.pm = fm + ((wgid % nig) % gsz); u.pn = (wgid % nig) / gsz; return true;
    }
};
struct OneUnit { Unit u; __device__ bool next(int i, Unit& o) const { if (i != 0) return false; o = u; return true; } };

typedef f32x4 Acc[2][2][4][2];

template <class Epi, class Sched>
__device__ __forceinline__ void gemm_phase(LAS unsigned char* lds, const Gemm g, const Sched& S, const Epi& E) {
    const int tid = threadIdx.x, wid = __builtin_amdgcn_readfirstlane(tid >> 6), lane = tid & 63, wr = wid >> 2, wc = wid & 3, fr = lane & 15, fq = lane >> 4;
    const int K = g.K, nt = K / BK;
    unsigned voffA[2], voffB[2];
#pragma unroll
    for (int i = 0; i < 2; ++i) { int R, C; stage_rc(tid * 16 + i * 8192, R, C); const int Rb = Epi::PERM ? ((R & ~31) + perm32(R & 31)) : R;
        voffA[i] = (unsigned)(R * g.lda + C) * 2u; voffB[i] = (unsigned)(Rb * g.ldb + C) * 2u; }
    const size_t kstep = (size_t)(BK * 2);
    const size_t hstepA = (size_t)HALF * g.lda * 2, hstepB = (size_t)HALF * g.ldb * 2;
    const size_t tstepA = 2 * hstepA, tstepB = 2 * hstepB;
    const unsigned ldsw = (unsigned)wid * 1024u;
    const int aoff = lds_byte(wr * 64 + fr, fq * 8), boff = lds_byte(wc * 32 + fr, fq * 8);
#define PG_SA(b, h) (((b) * 2 + (h)) * HTB)
#define PG_SB(b, h) ((4 + (b) * 2 + (h)) * HTB)
#define PG_STAGE(bufoff, gbase, voff) do { _Pragma("unroll") for (int _i = 0; _i < 2; ++_i) \
        __builtin_amdgcn_global_load_lds((const unsigned*)((const char*)(gbase) + (voff)[_i]), (LAS unsigned*)(lds + (bufoff) + ldsw + _i * 8192), 16, 0, 0); } while (0)
#define PG_LDA(dst, b, h) do { _Pragma("unroll") for (int m = 0; m < 4; ++m) _Pragma("unroll") for (int k = 0; k < 2; ++k) dst[m][k] = *(const LAS half8*)(lds + PG_SA(b, h) + aoff + m * 2048 + k * 1024); } while (0)
#define PG_LDB(dst, b, h) do { _Pragma("unroll") for (int n = 0; n < 2; ++n) _Pragma("unroll") for (int k = 0; k < 2; ++k) dst[n][k] = *(const LAS half8*)(lds + PG_SB(b, h) + boff + n * 2048 + k * 1024); } while (0)
#define PG_MMA(ai, bj, At, Bt) do { __builtin_amdgcn_s_setprio(1); _Pragma("unroll") for (int m = 0; m < 4; ++m) _Pragma("unroll") for (int n = 0; n < 2; ++n) _Pragma("unroll") for (int k = 0; k < 2; ++k) \
        acc[ai][bj][m][n] = __builtin_amdgcn_mfma_f32_16x16x32_f16(Bt[n][k], At[m][k], acc[ai][bj][m][n], 0, 0, 0); __builtin_amdgcn_s_setprio(0); } while (0)
#define PG_WAIT_V(n) asm volatile("s_waitcnt vmcnt(" #n ")" ::: "memory")
#define PG_WAIT_L(n) asm volatile("s_waitcnt lgkmcnt(" #n ")" ::: "memory")
#define PG_BAR __builtin_amdgcn_s_barrier()
#define PG_SCHED __builtin_amdgcn_sched_barrier(0)
    Unit cur, nxt; int ui = 0;
    if (!S.next(0, cur)) return;
    f32x4 acc[2][2][4][2];
#pragma unroll
    for (int a = 0; a < 2; ++a)
#pragma unroll
        for (int b = 0; b < 2; ++b)
#pragma unroll
            for (int m = 0; m < 4; ++m)
#pragma unroll
                for (int n = 0; n < 2; ++n) acc[a][b][m][n] = (f32x4){0.f, 0.f, 0.f, 0.f};
    half8 At[4][2], B0[2][2], B1[2][2];
    const char* cA = (const char*)g.A + (size_t)cur.pm * tstepA;
    const char* cB = (const char*)(g.Bt + (size_t)(cur.pm / g.bdiv) * g.bstride) + (size_t)cur.pn * tstepB;
    PG_STAGE(PG_SB(0, 0), cB, voffB); PG_STAGE(PG_SA(0, 0), cA, voffA); PG_STAGE(PG_SB(0, 1), cB + hstepB, voffB); PG_STAGE(PG_SA(0, 1), cA + hstepA, voffA);
    if (wr == 1) PG_BAR;
    PG_WAIT_V(4); PG_BAR;
    PG_STAGE(PG_SB(1, 0), cB + kstep, voffB); PG_STAGE(PG_SA(1, 0), cA + kstep, voffA); PG_STAGE(PG_SB(1, 1), cB + hstepB + kstep, voffB);
    PG_WAIT_V(6); PG_BAR;
    for (;;) {
        const bool has_next = S.next(ui + 1, nxt);
        const char* nA = has_next ? (const char*)g.A + (size_t)nxt.pm * tstepA : cA;
        const char* nB = has_next ? (const char*)(g.Bt + (size_t)(nxt.pm / g.bdiv) * g.bstride) + (size_t)nxt.pn * tstepB : cB;
        for (int t = 0; t < nt; t += 2) {
            const bool last = (t == nt - 2);
            const char* a1 = cA + (size_t)(t + 1) * kstep;
            const char* a2 = last ? nA : cA + (size_t)(t + 2) * kstep; const char* b2 = last ? nB : cB + (size_t)(t + 2) * kstep;
            const char* a3 = a2 + kstep; const char* b3 = b2 + kstep;
            PG_LDB(B0, 0, 0); PG_SCHED; PG_LDA(At, 0, 0); PG_STAGE(PG_SA(1, 1), a1 + hstepA, voffA);
            PG_WAIT_L(8); PG_BAR; PG_WAIT_L(0); PG_MMA(0, 0, At, B0); PG_BAR; PG_SCHED;
            PG_LDB(B1, 0, 1); PG_STAGE(PG_SB(0, 0), b2, voffB);
            PG_BAR; PG_WAIT_L(0); PG_MMA(0, 1, At, B1); PG_BAR;
            PG_LDA(At, 0, 1); PG_STAGE(PG_SA(0, 0), a2, voffA);
            PG_BAR; PG_WAIT_L(0); PG_MMA(1, 0, At, B0); PG_BAR; PG_SCHED;
            PG_STAGE(PG_SB(0, 1), b2 + hstepB, voffB);
            PG_WAIT_V(6); PG_BAR; PG_MMA(1, 1, At, B1); PG_BAR;
            PG_LDB(B0, 1, 0); PG_SCHED; PG_LDA(At, 1, 0); PG_STAGE(PG_SA(0, 1), a2 + hstepA, voffA);
            PG_WAIT_L(8); PG_BAR; PG_WAIT_L(0); PG_MMA(0, 0, At, B0); PG_BAR; PG_SCHED;
            PG_LDB(B1, 1, 1); PG_STAGE(PG_SB(1, 0), b3, voffB);
            PG_BAR; PG_WAIT_L(0); PG_MMA(0, 1, At, B1); PG_BAR;
            PG_LDA(At, 1, 1); PG_STAGE(PG_SA(1, 0), a3, voffA);
            PG_BAR; PG_WAIT_L(0); PG_MMA(1, 0, At, B0); PG_BAR; PG_SCHED;
            PG_STAGE(PG_SB(1, 1), b3 + hstepB, voffB);
            PG_WAIT_V(6); PG_BAR; PG_MMA(1, 1, At, B1); PG_BAR;
        }
        if constexpr (!Epi::AFTER_DRAIN) { E(acc, cur, wr, wc, fr, fq, lds + STAGE_BYTES); }
        if (!has_next) break;
#pragma unroll
        for (int a = 0; a < 2; ++a)
#pragma unroll
            for (int b = 0; b < 2; ++b)
#pragma unroll
                for (int m = 0; m < 4; ++m)
#pragma unroll
                    for (int n = 0; n < 2; ++n) acc[a][b][m][n] = (f32x4){0.f, 0.f, 0.f, 0.f};
        cur = nxt; cA = nA; cB = nB; ++ui;
    }
    PG_WAIT_V(0);
    if (wr == 0) PG_BAR;
    PG_BAR;
    if constexpr (Epi::AFTER_DRAIN) { E.fused(acc, cur, wr, wc, fr, fq, lds); }
#undef PG_SA
#undef PG_SB
#undef PG_STAGE
#undef PG_LDA
#undef PG_LDB
#undef PG_MMA
#undef PG_WAIT_V
#undef PG_WAIT_L
#undef PG_BAR
#undef PG_SCHED
}
}
namespace pg {
struct EpiHalf {
    static constexpr bool PERM = true, AFTER_DRAIN = false;
    h16* O; int ldc;
    __device__ __forceinline__ void operator()(const Acc& acc, const Unit& u, int wr, int wc, int fr, int fq, LAS unsigned char*) const {
        const int row0 = u.pm * BM + wr * 64 + fr, col0 = u.pn * BM + wc * 32 + 8 * fq;
#pragma unroll
        for (int ai = 0; ai < 2; ++ai)
#pragma unroll
            for (int m = 0; m < 4; ++m) { h16* rowp = O + (size_t)(row0 + ai * HALF + m * 16) * ldc + col0;
#pragma unroll
                for (int bj = 0; bj < 2; ++bj) { const f32x4 v0 = acc[ai][bj][m][0], v1 = acc[ai][bj][m][1];
                    u32x4 w; w.x = pk_h2(v0[0], v0[1]); w.y = pk_h2(v0[2], v0[3]); w.z = pk_h2(v1[0], v1[1]); w.w = pk_h2(v1[2], v1[3]);
                    *(u32x4*)(rowp + bj * HALF) = w; } }
    }
};
struct Epi1 {
    static constexpr bool PERM = true, AFTER_DRAIN = false;
    const float* rstd1; h16* UVZ; f32x2* lnst;
    __device__ __forceinline__ void operator()(const Acc& acc, const Unit& u, int wr, int wc, int fr, int fq, LAS unsigned char*) const {
        const int seg = u.pn >> 2, pnl = u.pn & 3;
        h16* base = UVZ + (size_t)seg * (16u << 20);
        const int row0 = u.pm * BM + wr * 64 + fr, col0 = pnl * BM + wc * 32 + 8 * fq;
#pragma unroll
        for (int ai = 0; ai < 2; ++ai)
#pragma unroll
            for (int m = 0; m < 4; ++m) { const int row = row0 + ai * HALF + m * 16; const float rs = rstd1[row]; h16* rowp = base + (size_t)row * 1024 + col0;
                float s = 0.f, ss = 0.f;
#pragma unroll
                for (int bj = 0; bj < 2; ++bj) { f32x4 v0 = acc[ai][bj][m][0] * rs, v1 = acc[ai][bj][m][1] * rs;
                    if (seg < 2) { f32x2 a = gelu_pk((f32x2){v0[0], v0[1]}), b = gelu_pk((f32x2){v0[2], v0[3]}), c = gelu_pk((f32x2){v1[0], v1[1]}), d = gelu_pk((f32x2){v1[2], v1[3]});
                        v0 = (f32x4){a.x, a.y, b.x, b.y}; v1 = (f32x4){c.x, c.y, d.x, d.y}; }
                    if (seg == 1) { s += (v0[0] + v0[1]) + (v0[2] + v0[3]) + (v1[0] + v1[1]) + (v1[2] + v1[3]);
                        ss += (v0[0] * v0[0] + v0[1] * v0[1]) + (v0[2] * v0[2] + v0[3] * v0[3]) + (v1[0] * v1[0] + v1[1] * v1[1]) + (v1[2] * v1[2] + v1[3] * v1[3]); }
                    u32x4 w; w.x = pk_h2(v0[0], v0[1]); w.y = pk_h2(v0[2], v0[3]); w.z = pk_h2(v1[0], v1[1]); w.w = pk_h2(v1[2], v1[3]);
                    *(u32x4*)(rowp + bj * HALF) = w; }
                if (seg == 1) { s += __shfl_xor(s, 16); s += __shfl_xor(s, 32); ss += __shfl_xor(ss, 16); ss += __shfl_xor(ss, 32);
                    if (fq == 0) lnst[(size_t)row * 16 + pnl * 4 + wc] = (f32x2){s, ss}; } }
    }
};
struct EpiRes {
    static constexpr bool PERM = true, AFTER_DRAIN = false;
    const float* res; float* out; h16* o16; float* ssq;
    __device__ __forceinline__ void operator()(const Acc& acc, const Unit& u, int wr, int wc, int fr, int fq, LAS unsigned char*) const {
        const int row0 = u.pm * BM + wr * 64 + fr, col0 = u.pn * BM + wc * 32 + 8 * fq;
#pragma unroll
        for (int ai = 0; ai < 2; ++ai)
#pragma unroll
            for (int m = 0; m < 4; ++m) { const int row = row0 + ai * HALF + m * 16; const size_t off = (size_t)row * 2048 + col0; float q = 0.f;
#pragma unroll
                for (int bj = 0; bj < 2; ++bj) { const f32x4 r0 = *(const f32x4*)(res + off + bj * HALF), r1 = *(const f32x4*)(res + off + bj * HALF + 4);
                    const f32x4 v0 = acc[ai][bj][m][0] + r0, v1 = acc[ai][bj][m][1] + r1;
                    *(f32x4*)(out + off + bj * HALF) = v0; *(f32x4*)(out + off + bj * HALF + 4) = v1;
                    u32x4 w; w.x = pk_h2(v0[0], v0[1]); w.y = pk_h2(v0[2], v0[3]); w.z = pk_h2(v1[0], v1[1]); w.w = pk_h2(v1[2], v1[3]);
                    *(u32x4*)(o16 + off + bj * HALF) = w;
                    q += (v0[0] * v0[0] + v0[1] * v0[1]) + (v0[2] * v0[2] + v0[3] * v0[3]) + (v1[0] * v1[0] + v1[1] * v1[1]) + (v1[2] * v1[2] + v1[3] * v1[3]); }
                q += __shfl_xor(q, 16); q += __shfl_xor(q, 32);
                if (fq == 0) ssq[(size_t)row * 32 + u.pn * 4 + wc] = q;
                asm volatile("" ::: "memory"); }
    }
};
__device__ __forceinline__ float row_rstd(const float* ssq, int row, int fq) {
    const float* p = ssq + (size_t)row * 32 + fq * 8; const f32x4 a = *(const f32x4*)p, b = *(const f32x4*)(p + 4);
    float q = ((a[0] + a[1]) + (a[2] + a[3])) + ((b[0] + b[1]) + (b[2] + b[3]));
    q += __shfl_xor(q, 16); q += __shfl_xor(q, 32);
    return rsqrtf(q * (1.0f / 2048.0f) + EPS_);
}
struct EpiSoftmax {
    static constexpr bool PERM = true, AFTER_DRAIN = true;
    const float* ssq2; h16* P;
    __device__ __forceinline__ void fused(Acc& acc, const Unit& u, int wr, int wc, int fr, int fq, LAS unsigned char* lds) const {
        LAS f32x2* X = (LAS f32x2*)lds;
        float mxs[2][4];
#pragma unroll
        for (int ai = 0; ai < 2; ++ai)
#pragma unroll
            for (int m = 0; m < 4; ++m) { const int rl = ai * HALF + wr * 64 + m * 16 + fr; const int row = u.pm * BM + rl;
                const float rs = row_rstd(ssq2, row, fq) * 0.044194173824159216f;
                float mx = -INFINITY;
#pragma unroll
                for (int bj = 0; bj < 2; ++bj)
#pragma unroll
                    for (int n = 0; n < 2; ++n) { f32x4 v = acc[ai][bj][m][n] * rs; acc[ai][bj][m][n] = v; mx = fmaxf(mx, fmaxf(fmaxf(v[0], v[1]), fmaxf(v[2], v[3]))); }
                mx = fmaxf(mx, __shfl_xor(mx, 16)); mx = fmaxf(mx, __shfl_xor(mx, 32));
                float l = 0.f;
#pragma unroll
                for (int bj = 0; bj < 2; ++bj)
#pragma unroll
                    for (int n = 0; n < 2; ++n) { f32x4 v = acc[ai][bj][m][n]; v[0] = __expf(v[0] - mx); v[1] = __expf(v[1] - mx); v[2] = __expf(v[2] - mx); v[3] = __expf(v[3] - mx);
                        acc[ai][bj][m][n] = v; l += (v[0] + v[1]) + (v[2] + v[3]); }
                l += __shfl_xor(l, 16); l += __shfl_xor(l, 32);
                if (fq == 0) X[rl * 4 + wc] = (f32x2){mx, l};
                mxs[ai][m] = mx; }
        asm volatile("s_waitcnt lgkmcnt(0)" ::: "memory"); __builtin_amdgcn_s_barrier(); asm volatile("" ::: "memory");
        const int col0 = u.pn * BM + wc * 32 + 8 * fq;
#pragma unroll
        for (int ai = 0; ai < 2; ++ai)
#pragma unroll
            for (int m = 0; m < 4; ++m) { const int rl = ai * HALF + wr * 64 + m * 16 + fr; const int row = u.pm * BM + rl;
                const f32x2 x0 = X[rl * 4 + 0], x1 = X[rl * 4 + 1], x2 = X[rl * 4 + 2], x3 = X[rl * 4 + 3];
                const float M = fmaxf(fmaxf(x0.x, x1.x), fmaxf(x2.x, x3.x));
                const float L = x0.y * __expf(x0.x - M) + x1.y * __expf(x1.x - M) + x2.y * __expf(x2.x - M) + x3.y * __expf(x3.x - M);
                const float f = __expf(mxs[ai][m] - M) / L;
                h16* rowp = P + (size_t)row * 1024 + col0;
#pragma unroll
                for (int bj = 0; bj < 2; ++bj) { const f32x4 v0 = acc[ai][bj][m][0] * f, v1 = acc[ai][bj][m][1] * f;
                    u32x4 w; w.x = pk_h2(v0[0], v0[1]); w.y = pk_h2(v0[2], v0[3]); w.z = pk_h2(v1[0], v1[1]); w.w = pk_h2(v1[2], v1[3]);
                    *(u32x4*)(rowp + bj * HALF) = w; } }
    }
};
struct EpiScore {
    static constexpr bool PERM = false, AFTER_DRAIN = false;
    const float* ssq3; float* S;
    __device__ __forceinline__ void operator()(const Acc& acc, const Unit& u, int wr, int wc, int fr, int fq, LAS unsigned char*) const {
        const int row0 = u.pm * BM + wr * 64 + fr, col0 = u.pn * BM + wc * 32 + 4 * fq;
#pragma unroll
        for (int ai = 0; ai < 2; ++ai)
#pragma unroll
            for (int m = 0; m < 4; ++m) { const int row = row0 + ai * HALF + m * 16; const float rs = row_rstd(ssq3, row, fq); float* rowp = S + (size_t)row * 2048 + col0;
#pragma unroll
                for (int bj = 0; bj < 2; ++bj)
#pragma unroll
                    for (int n = 0; n < 2; ++n) *(f32x4*)(rowp + bj * HALF + n * 16) = acc[ai][bj][m][n] * rs; }
    }
};
}

__device__ __forceinline__ void conv_trans_tile(const float* __restrict__ src, int ldsrc, int k0, int n0, h16* __restrict__ dst, int lddst, const float* __restrict__ rs, int rs_off, LAS unsigned char* lds) {
  LAS h16* tile = (LAS h16*)lds;
  const int tid = threadIdx.x;
  const int c4 = tid & 31, r = tid >> 5;
  f32x4 v[4];
#pragma unroll
  for (int p = 0; p < 4; ++p) v[p] = *(const f32x4*)(src + (size_t)(k0 + r + 16 * p) * ldsrc + n0 + c4 * 4);
  __syncthreads();
#pragma unroll
  for (int p = 0; p < 4; ++p) { const int k = r + 16 * p; float s = 1.0f; if (rs) { int kk = k0 + k + rs_off; s = kk >= 0 ? rs[kk] : 1.0f; }
#pragma unroll
    for (int j = 0; j < 4; ++j) tile[(c4 * 4 + j) * 72 + k] = (h16)(v[p][j] * s); }
  __syncthreads();
#pragma unroll
  for (int p = 0; p < 2; ++p) { const int n = (tid >> 3) + 64 * p, k8 = (tid & 7) * 8;
    const u32x4 w = *(const LAS u32x4*)(tile + n * 72 + k8);
    *(u32x4*)(dst + (size_t)(n0 + n) * lddst + k0 + k8) = w; }
}
__device__ __forceinline__ void conv_copy_rows(const float* __restrict__ src, int ldsrc, int r0, int rows, int cols, h16* __restrict__ dst, int lddst, const float* __restrict__ rs) {
  const int per_row = cols >> 3, total = rows * per_row;
  for (int i = threadIdx.x; i < total; i += NTHREADS) { const int r = r0 + i / per_row, c = (i % per_row) * 8;
    const float s = rs ? rs[r] : 1.0f;
    const f32x4 a = *(const f32x4*)(src + (size_t)r * ldsrc + c), b = *(const f32x4*)(src + (size_t)r * ldsrc + c + 4);
    u32x4 w; w.x = pk_h2(a[0] * s, a[1] * s); w.y = pk_h2(a[2] * s, a[3] * s); w.z = pk_h2(b[0] * s, b[1] * s); w.w = pk_h2(b[2] * s, b[3] * s);
    *(u32x4*)(dst + (size_t)r * lddst + c) = w; }
}
__device__ __forceinline__ void conv_rows_norm(const float* __restrict__ x, int row0, h16* __restrict__ x16, float* __restrict__ rstd_out, const float* __restrict__ g) {
  const int lane = threadIdx.x & 63, row = row0 + (threadIdx.x >> 6);
  const float* xr = x + (size_t)row * 2048; f32x4 a[4], b[4]; float ss = 0.f;
#pragma unroll
  for (int j = 0; j < 4; ++j) { a[j] = *(const f32x4*)(xr + (j * 64 + lane) * 8); b[j] = *(const f32x4*)(xr + (j * 64 + lane) * 8 + 4);
    ss += (a[j][0] * a[j][0] + a[j][1] * a[j][1]) + (a[j][2] * a[j][2] + a[j][3] * a[j][3]) + (b[j][0] * b[j][0] + b[j][1] * b[j][1]) + (b[j][2] * b[j][2] + b[j][3] * b[j][3]); }
  ss = wave_sum(ss);
  const float r = rsqrtf(ss * (1.0f / 2048.0f) + EPS_);
  if (rstd_out && lane == 0) rstd_out[row] = r;
#pragma unroll
  for (int j = 0; j < 4; ++j) { f32x4 p = a[j], q = b[j];
    if (g) { const f32x4 g0 = *(const f32x4*)(g + (j * 64 + lane) * 8), g1 = *(const f32x4*)(g + (j * 64 + lane) * 8 + 4); p = p * g0 * r; q = q * g1 * r; }
    u32x4 w; w.x = pk_h2(p[0], p[1]); w.y = pk_h2(p[2], p[3]); w.z = pk_h2(q[0], q[1]); w.w = pk_h2(q[2], q[3]);
    *(u32x4*)(x16 + (size_t)row * 2048 + (j * 64 + lane) * 8) = w; }
}
__device__ __forceinline__ void conv_table_rows(const float* __restrict__ tab, int row0, unsigned char* __restrict__ t8, float* __restrict__ sc) {
  const int lane = threadIdx.x & 63, row = row0 + (threadIdx.x >> 6);
  const float* xr = tab + (size_t)row * 2048; f32x4 a[4], b[4]; float mx = 0.f;
#pragma unroll
  for (int j = 0; j < 4; ++j) { a[j] = *(const f32x4*)(xr + (j * 64 + lane) * 8); b[j] = *(const f32x4*)(xr + (j * 64 + lane) * 8 + 4);
    mx = fmaxf(mx, fmaxf(fmaxf(fabsf(a[j][0]), fabsf(a[j][1])), fmaxf(fabsf(a[j][2]), fabsf(a[j][3]))));
    mx = fmaxf(mx, fmaxf(fmaxf(fabsf(b[j][0]), fabsf(b[j][1])), fmaxf(fabsf(b[j][2]), fabsf(b[j][3])))); }
  mx = wave_max(mx);
  const float s = mx > 0.f ? 400.0f / mx : 1.0f;
  if (lane == 0) sc[row] = mx > 0.f ? mx * (1.0f / 400.0f) : 1.0f;
#pragma unroll
  for (int j = 0; j < 4; ++j) { int w0 = __builtin_amdgcn_cvt_pk_fp8_f32(a[j][0] * s, a[j][1] * s, 0, false); w0 = __builtin_amdgcn_cvt_pk_fp8_f32(a[j][2] * s, a[j][3] * s, w0, true);
    int w1 = __builtin_amdgcn_cvt_pk_fp8_f32(b[j][0] * s, b[j][1] * s, 0, false); w1 = __builtin_amdgcn_cvt_pk_fp8_f32(b[j][2] * s, b[j][3] * s, w1, true);
    u32x2 w; w.x = (unsigned)w0; w.y = (unsigned)w1;
    *(u32x2*)(t8 + (size_t)row * 2048 + (j * 64 + lane) * 8) = w; }
}
__device__ __forceinline__ void sgu_pool_item(int nb, int q, const h16* __restrict__ U, const h16* __restrict__ V, const h16* __restrict__ Z, const f32x2* __restrict__ lnst,
                                              const float* __restrict__ ln_g, const float* __restrict__ ln_b, const h16* __restrict__ Wsgu, const float* __restrict__ sgu_b,
                                              h16* __restrict__ A2, LAS unsigned char* lds) {
  const int tid = threadIdx.x, lane = tid & 63, wid = tid >> 6;
  LAS h16* vt = (LAS h16*)lds;
  LAS f32x2* stat = (LAS f32x2*)(lds + 36864);
  const int t0 = nb * 128;
  __syncthreads();
  if (tid < 128) { const f32x2* p = lnst + (size_t)(t0 + tid) * 16; float s = 0.f, ss = 0.f;
#pragma unroll
    for (int i = 0; i < 16; ++i) { const f32x2 v = p[i]; s += v.x; ss += v.y; }
    const float mean = s * (1.0f / 1024.0f); const float var = fmaxf(ss * (1.0f / 1024.0f) - mean * mean, 0.f);
    stat[tid] = (f32x2){mean, rsqrtf(var + EPS_)}; }
  __syncthreads();
  for (int hh = 0; hh < 4; ++hh) {
    const int h = 4 * q + hh;
#pragma unroll
    for (int i = 0; i < 4; ++i) { const int ch = tid + NTHREADS * i; const int j = ch >> 4, d8 = (ch & 15) * 8;
      const half8 v = *(const half8*)(V + (size_t)(t0 + j) * 1024 + h * 128 + d8);
      const f32x2 st = stat[j];
      const f32x4 g0 = *(const f32x4*)(ln_g + h * 128 + d8), g1 = *(const f32x4*)(ln_g + h * 128 + d8 + 4), b0 = *(const f32x4*)(ln_b + h * 128 + d8), b1 = *(const f32x4*)(ln_b + h * 128 + d8 + 4);
#pragma unroll
      for (int e = 0; e < 8; ++e) { const float gg = e < 4 ? g0[e & 3] : g1[e & 3], bb = e < 4 ? b0[e & 3] : b1[e & 3];
        vt[(d8 + e) * 136 + j] = (h16)(((float)v[e] - st.x) * st.y * gg + bb); } }
    __syncthreads();
    f32x4 acc[8];
#pragma unroll
    for (int nt = 0; nt < 8; ++nt) acc[nt] = (f32x4){0.f, 0.f, 0.f, 0.f};
    const int i_row = 16 * wid + (lane & 15);
    const int ksteps = (wid < 4) ? 2 : 4;
    for (int kk = 0; kk < ksteps; ++kk) {
      const half8 wf = *(const half8*)(Wsgu + ((size_t)h * 128 + i_row) * 128 + kk * 32 + 8 * (lane >> 4));
#pragma unroll
      for (int nt = 0; nt < 8; ++nt) { const half8 vf = *(const LAS half8*)(vt + (16 * nt + (lane & 15)) * 136 + kk * 32 + 8 * (lane >> 4));
        acc[nt] = __builtin_amdgcn_mfma_f32_16x16x32_f16(vf, wf, acc[nt], 0, 0, 0); }
    }
    const float bias = sgu_b[h * 128 + i_row];
    const size_t tok = (size_t)(t0 + i_row);
#pragma unroll
    for (int nt = 0; nt < 8; ++nt) { const int d0 = 16 * nt + 4 * (lane >> 4);
      const half4 uu = *(const half4*)(U + tok * 1024 + h * 128 + d0);
      u32x2 w; w.x = pk_h2((float)uu[0] * (acc[nt][0] + bias), (float)uu[1] * (acc[nt][1] + bias)); w.y = pk_h2((float)uu[2] * (acc[nt][2] + bias), (float)uu[3] * (acc[nt][3] + bias));
      *(u32x2*)(A2 + tok * 2048 + h * 128 + d0) = w; }
    __syncthreads();
  }
  { const int cc = tid & 63, tr = tid >> 6; const int col = 512 * q + cc * 8; const int g = col >> 8, w = 2 << g;
    const int tfirst = t0 + tr * 16; const int pos0 = tfirst & (SEQ_ - 1);
    float sum[8];
#pragma unroll
    for (int e = 0; e < 8; ++e) sum[e] = 0.f;
    for (int s = 1; s < w; ++s) { if (pos0 - s >= 0) { const half8 z = *(const half8*)(Z + (size_t)(tfirst - s) * 1024 + col);
#pragma unroll
        for (int e = 0; e < 8; ++e) sum[e] += (float)z[e]; } }
    for (int i = 0; i < 16; ++i) { const int t = tfirst + i, pos = pos0 + i;
      const half8 z = *(const half8*)(Z + (size_t)t * 1024 + col);
#pragma unroll
      for (int e = 0; e < 8; ++e) sum[e] += (float)z[e];
      const int cnt = pos + 1 < w ? pos + 1 : w; const float inv = 1.0f / (float)cnt;
      u32x4 o; float y[8];
#pragma unroll
      for (int e = 0; e < 8; ++e) y[e] = sum[e] * inv - (float)z[e];
      o.x = pk_h2(y[0], y[1]); o.y = pk_h2(y[2], y[3]); o.z = pk_h2(y[4], y[5]); o.w = pk_h2(y[6], y[7]);
      *(u32x4*)(A2 + (size_t)t * 2048 + 1024 + col) = o;
      if (pos - w + 1 >= 0) { const half8 zo = *(const half8*)(Z + (size_t)(t - w + 1) * 1024 + col);
#pragma unroll
        for (int e = 0; e < 8; ++e) sum[e] -= (float)zo[e]; } }
  }
}
constexpr int P6_TS = 0, P6_TI = 32768, P6_IG = 40960, P6_GU = 73728, P6_GV = 106496;
__device__ __forceinline__ void peer_topk(const float* S, const float* SU, const float* SV, int tw0, LAS unsigned char* lds) {
  LAS float* ts = (LAS float*)(lds + P6_TS); LAS unsigned char* ti = lds + P6_TI; LAS int* ig = (LAS int*)(lds + P6_IG); LAS float* gu = (LAS float*)(lds + P6_GU); LAS float* gv = (LAS float*)(lds + P6_GV);
  const int tid = threadIdx.x;
  for (int r = 0; r < 2; ++r) {
    { const int tl = tid >> 4, l = tid & 15; const int t = tw0 + 32 * r + tl;
      const float* sp = S + (size_t)t * 2048 + l * 128;
      float v[16]; int ix[16];
#pragma unroll
      for (int k = 0; k < 16; ++k) { v[k] = -INFINITY; ix[k] = 0; }
      for (int j4 = 0; j4 < 32; ++j4) { const f32x4 x4 = *(const f32x4*)(sp + j4 * 4);
#pragma unroll
        for (int e = 0; e < 4; ++e) { float x = x4[e]; int xi = j4 * 4 + e;
#pragma unroll
          for (int k = 0; k < 16; ++k) { const bool gt = x > v[k]; const float tv = gt ? v[k] : x; const int tix = gt ? ix[k] : xi; v[k] = gt ? x : v[k]; ix[k] = gt ? xi : ix[k]; x = tv; xi = tix; } } }
      __syncthreads();
#pragma unroll
      for (int k = 0; k < 16; ++k) { ts[(tl * 16 + l) * 16 + k] = v[k]; ti[(tl * 16 + l) * 16 + k] = (unsigned char)ix[k]; }
    }
    __syncthreads();
    if (tid < 256) { const int tl = tid >> 3, h = tid & 7;
      LAS const float* pa = ts + (tl * 16 + 2 * h) * 16; LAS const float* pb = pa + 16;
      float a[16], b[16];
#pragma unroll
      for (int k = 0; k < 16; ++k) { a[k] = pa[k]; b[k] = pb[k]; }
      float bs[16]; int bc[16];
#pragma unroll
      for (int k = 0; k < 16; ++k) { bs[k] = -INFINITY; bc[k] = 0; }
#pragma unroll
      for (int i = 0; i < 16; ++i)
#pragma unroll
        for (int j = 0; j < 16; ++j) if ((i + 1) * (j + 1) <= 16) { float x = a[i] + b[j]; int xi = i * 16 + j;
#pragma unroll
          for (int k = 0; k < 16; ++k) { const bool gt = x > bs[k]; const float tv = gt ? bs[k] : x; const int tix = gt ? bc[k] : xi; bs[k] = gt ? x : bs[k]; bc[k] = gt ? xi : bc[k]; x = tv; xi = tix; } }
      float ex[16]; float sum = 0.f;
#pragma unroll
      for (int k = 0; k < 16; ++k) { ex[k] = __expf(bs[k] - bs[0]); sum += ex[k]; }
      const float inv = 1.0f / sum;
      LAS const unsigned char* ia = ti + (tl * 16 + 2 * h) * 16; LAS const unsigned char* ib = ia + 16;
#pragma unroll
      for (int k = 0; k < 16; ++k) { const int id = (int)ia[bc[k] >> 4] * 128 + (int)ib[bc[k] & 15]; const int o = (32 * r + tl) * 128 + h * 16 + k;
        ig[o] = id; gu[o] = SU[id]; gv[o] = ex[k] * inv * SV[id]; }
    }
  }
  __syncthreads();
}

struct RowBuf { u32x4 u0, u1, v0, v1; };
__device__ __forceinline__ void fp8x4_to_f32(unsigned w, float* o) { const f32x2 lo = __builtin_amdgcn_cvt_pk_f32_fp8((int)w, false), hi = __builtin_amdgcn_cvt_pk_f32_fp8((int)w, true); o[0] = lo.x; o[1] = lo.y; o[2] = hi.x; o[3] = hi.y; }

__device__ __forceinline__ void peer_gather_wave(float* h2, const unsigned char* U8, const unsigned char* V8, const float* __restrict__ g_peer, const float* __restrict__ g_final,
                                                 int t0, int tl0, int ntok, LAS unsigned char* lds) {
  LAS const int* ig = (LAS const int*)(lds + P6_IG); LAS const float* gu = (LAS const float*)(lds + P6_GU); LAS const float* gv = (LAS const float*)(lds + P6_GV);
  const int lane = threadIdx.x & 63;
  for (int it = 0; it < ntok; ++it) {
    const int t = t0 + it, tl = tl0 + it;
    asm volatile("" ::: "memory");
    float* hr = h2 + (size_t)t * 2048;
    float n[32], acc[32]; float ss = 0.f;
#pragma unroll
    for (int j = 0; j < 2; ++j)
#pragma unroll
      for (int q = 0; q < 4; ++q) { const f32x4 x = *(const f32x4*)(hr + (j * 64 + lane) * 16 + q * 4);
        n[j * 16 + q * 4 + 0] = x[0]; n[j * 16 + q * 4 + 1] = x[1]; n[j * 16 + q * 4 + 2] = x[2]; n[j * 16 + q * 4 + 3] = x[3];
        ss += (x[0] * x[0] + x[1] * x[1]) + (x[2] * x[2] + x[3] * x[3]); }
    ss = wave_sum(ss);
    const float r3 = rsqrtf(ss * (1.0f / 2048.0f) + EPS_);
#pragma unroll
    for (int j = 0; j < 2; ++j)
#pragma unroll
      for (int q = 0; q < 4; ++q) { const f32x4 g = *(const f32x4*)(g_peer + (j * 64 + lane) * 16 + q * 4);
#pragma unroll
        for (int e = 0; e < 4; ++e) { n[j * 16 + q * 4 + e] *= r3 * g[e]; acc[j * 16 + q * 4 + e] = 0.f; } }
    LAS const int* igt = ig + tl * 128; LAS const float* gut = gu + tl * 128; LAS const float* gvt = gv + tl * 128;
#define P6_LOAD(B, E) do { const int _id = __builtin_amdgcn_readfirstlane(igt[(E) < 128 ? (E) : 127]); const unsigned char* _up = U8 + (size_t)_id * 2048 + lane * 16; const unsigned char* _vp = V8 + (size_t)_id * 2048 + lane * 16; \
      B.u0 = *(const u32x4*)_up; B.u1 = *(const u32x4*)(_up + 1024); B.v0 = *(const u32x4*)_vp; B.v1 = *(const u32x4*)(_vp + 1024); } while (0)
#define P6_PROC(B, E) do { float dot = 0.f; float f[4]; \
      _Pragma("unroll") for (int q = 0; q < 4; ++q) { fp8x4_to_f32(B.u0[q], f); dot += (f[0] * n[q * 4 + 0] + f[1] * n[q * 4 + 1]) + (f[2] * n[q * 4 + 2] + f[3] * n[q * 4 + 3]); } \
      _Pragma("unroll") for (int q = 0; q < 4; ++q) { fp8x4_to_f32(B.u1[q], f); dot += (f[0] * n[16 + q * 4 + 0] + f[1] * n[16 + q * 4 + 1]) + (f[2] * n[16 + q * 4 + 2] + f[3] * n[16 + q * 4 + 3]); } \
      dot = wave_sum(dot) * gut[E]; const float a = gelu_f(dot) * gvt[E]; \
      _Pragma("unroll") for (int q = 0; q < 4; ++q) { fp8x4_to_f32(B.v0[q], f); acc[q * 4 + 0] += a * f[0]; acc[q * 4 + 1] += a * f[1]; acc[q * 4 + 2] += a * f[2]; acc[q * 4 + 3] += a * f[3]; } \
      _Pragma("unroll") for (int q = 0; q < 4; ++q) { fp8x4_to_f32(B.v1[q], f); acc[16 + q * 4 + 0] += a * f[0]; acc[16 + q * 4 + 1] += a * f[1]; acc[16 + q * 4 + 2] += a * f[2]; acc[16 + q * 4 + 3] += a * f[3]; } } while (0)
    RowBuf b0, b1, b2, b3;
    P6_LOAD(b0, 0); P6_LOAD(b1, 1); P6_LOAD(b2, 2); P6_LOAD(b3, 3);
    for (int e = 0; e < 128; e += 4) {
      P6_PROC(b0, e);     P6_LOAD(b0, e + 4);
      P6_PROC(b1, e + 1); P6_LOAD(b1, e + 5);
      P6_PROC(b2, e + 2); P6_LOAD(b2, e + 6);
      P6_PROC(b3, e + 3); P6_LOAD(b3, e + 7);
    }
#undef P6_LOAD
#undef P6_PROC
    asm volatile("" ::: "memory");
    float s2 = 0.f;
#pragma unroll
    for (int j = 0; j < 2; ++j)
#pragma unroll
      for (int q = 0; q < 4; ++q) { const f32x4 x = *(const f32x4*)(hr + (j * 64 + lane) * 16 + q * 4);
#pragma unroll
        for (int e = 0; e < 4; ++e) { const float hh = x[e] + acc[j * 16 + q * 4 + e]; acc[j * 16 + q * 4 + e] = hh; s2 += hh * hh; } }
    s2 = wave_sum(s2);
    const float rf = rsqrtf(s2 * (1.0f / 2048.0f) + EPS_);
#pragma unroll
    for (int j = 0; j < 2; ++j)
#pragma unroll
      for (int q = 0; q < 4; ++q) { const f32x4 g = *(const f32x4*)(g_final + (j * 64 + lane) * 16 + q * 4); f32x4 o;
#pragma unroll
        for (int e = 0; e < 4; ++e) o[e] = acc[j * 16 + q * 4 + e] * rf * g[e];
        *(f32x4*)(hr + (j * 64 + lane) * 16 + q * 4) = o; }
  }
}
struct Args { const float* in[22]; float* out; unsigned char* ws; int ph_lo, ph_hi; };

__device__ __forceinline__ void p0a_chunk(int id, const Args& a, LAS unsigned char* lds) {
  unsigned char* ws = a.ws;
  const float* mem = a.in[1]; const float* g_mix = a.in[2]; const float* w_in = a.in[3]; const float* pool_w = a.in[8]; const float* g_mem = a.in[12]; const float* w_kv = a.in[14];
  const float* g_peer = a.in[16]; const float* w_query = a.in[17]; const float* sub_keys = a.in[18];
  if (id < 1024) { conv_trans_tile(w_kv, 4096, (id >> 5) * 64, (id & 31) * 128, (h16*)(ws + O_WKVT), 2048, nullptr, 0, lds); return; }
  id -= 1024;
  if (id < 64) { conv_rows_norm(mem, id * 8, (h16*)(ws + O_M16), nullptr, g_mem); return; }
  id -= 64;
  if (id < 128) { conv_copy_rows(w_in + 2048, 3072, id * 16, 16, 1024, (h16*)(ws + O_WINZ), 1024, g_mix); return; }
  id -= 128;
  if (id < 32) { const int g = id >> 3, t = id & 7; conv_trans_tile(pool_w + (size_t)g * 65536, 256, (t >> 1) * 64, (t & 1) * 128, (h16*)(ws + O_WPOOLT) + (size_t)g * 65536, 256, nullptr, 0, lds); return; }
  id -= 32;
  if (id < 256) { conv_copy_rows(w_query, 2048, id * 8, 8, 2048, (h16*)(ws + O_WQRY), 2048, g_peer); return; }
  id -= 256;
  { h16* dst = (h16*)(ws + O_SKBD);
    for (int i = threadIdx.x; i < 2048; i += NTHREADS) { const int e0 = id * 16384 + i * 8; const int h = e0 >> 16, r = (e0 >> 8) & 255, c = e0 & 255; const int p = r >> 7, key = r & 127, pp = c >> 7, cc = c & 127;
      u32x4 w = (u32x4){0u, 0u, 0u, 0u};
      if (p == pp) { const float* s = sub_keys + ((size_t)((h * 2 + p) * 128 + key)) * 128 + cc; const f32x4 x = *(const f32x4*)s, y = *(const f32x4*)(s + 4);
        w.x = pk_h2(x[0], x[1]); w.y = pk_h2(x[2], x[3]); w.z = pk_h2(y[0], y[1]); w.w = pk_h2(y[2], y[3]); }
      *(u32x4*)(dst + e0) = w; } }
}
constexpr int P0A_CHUNKS = 1024 + 64 + 128 + 32 + 256 + 32;

__device__ __forceinline__ void p0b_chunk(int id, const Args& a, LAS unsigned char* lds) {
  unsigned char* ws = a.ws;
  const float* x = a.in[0]; const float* g_mix = a.in[2]; const float* w_in = a.in[3]; const float* sgu_w = a.in[6]; const float* pool_scale = a.in[9]; const float* w_out = a.in[10];
  const float* g_xattn = a.in[11]; const float* w_q = a.in[13]; const float* w_o = a.in[15]; const float* peer_u = a.in[19]; const float* peer_v = a.in[20];
  if (id < 2048) { conv_rows_norm(x, id * 8, (h16*)(ws + O_RA), (float*)(ws + O_RSTD1), nullptr); return; }
  id -= 2048;
  if (id < 512) { conv_trans_tile(w_in, 3072, (id >> 4) * 64, (id & 15) * 128, (h16*)(ws + O_W1T), 2048, g_mix, 0, lds); return; }
  id -= 512;
  if (id < 512) { conv_trans_tile(w_out, 2048, (id >> 4) * 64, (id & 15) * 128, (h16*)(ws + O_W3T), 2048, pool_scale, -1024, lds); return; }
  id -= 512;
  if (id < 512) { conv_trans_tile(w_o, 2048, (id >> 4) * 64, (id & 15) * 128, (h16*)(ws + O_WOT), 2048, nullptr, 0, lds); return; }
  id -= 512;
  if (id < 256) { conv_copy_rows(w_q, 2048, id * 8, 8, 2048, (h16*)(ws + O_WQ16), 2048, g_xattn); return; }
  id -= 256;
  if (id < 8) { h16* dst = (h16*)(ws + O_WSGU);
    for (int i = threadIdx.x; i < 2048; i += NTHREADS) { const int e0 = id * 16384 + i * 8; const int ii = (e0 >> 7) & 127, j = e0 & 127;
      u32x4 w = (u32x4){0u, 0u, 0u, 0u};
      if ((j >> 6) <= (ii >> 6)) { const f32x4 p = *(const f32x4*)(sgu_w + e0), q = *(const f32x4*)(sgu_w + e0 + 4); w.x = pk_h2(p[0], p[1]); w.y = pk_h2(p[2], p[3]); w.z = pk_h2(q[0], q[1]); w.w = pk_h2(q[2], q[3]); }
      *(u32x4*)(dst + e0) = w; }
    return; }
  id -= 8;
  if (id < 2048) { conv_table_rows(peer_u, id * 8, ws + O_U8, (float*)(ws + O_SU)); return; }
  id -= 2048;
  conv_table_rows(peer_v, id * 8, ws + O_V8, (float*)(ws + O_SV));
}
constexpr int P0B_CHUNKS = 2048 + 512 * 3 + 256 + 8 + 4096;

#define XB_TMO      128
#define XB_XCNT(j)  (256  + 64 * (j))
#define XB_XSUB(j)  (1280 + 64 * (j))
#define XB_XGEN(j)  (2304 + 64 * (j))
#define XB_TOP      3328
#define XB_TOPGEN   3392
#define XCD_BAR_WORDS 3456
#define XB_SPIN_CAP (1u << 20)
__device__ __forceinline__ unsigned xb_ld(unsigned* p)              { return __hip_atomic_load(p, __ATOMIC_RELAXED, __HIP_MEMORY_SCOPE_AGENT); }
__device__ __forceinline__ unsigned xb_add(unsigned* p, unsigned v) { return __hip_atomic_fetch_add(p, v, __ATOMIC_RELAXED, __HIP_MEMORY_SCOPE_AGENT); }
__device__ __forceinline__ unsigned xb_xcc_id() { return (unsigned)__builtin_amdgcn_s_getreg((3 << 11) | 20) & 0xFu; }
#define XB_SPIN(cond, bar) do { unsigned _sp = 0; while (cond) { __builtin_amdgcn_s_sleep(1); \
    if ((++_sp & 255u) == 0u) { if (xb_ld(&(bar)[XB_TMO])) break; if (_sp > XB_SPIN_CAP) { atomicAdd(&(bar)[XB_TMO], 1u); break; } } } } while (0)
struct XcdBarrier { unsigned* bar; unsigned x; volatile LAS unsigned* st; };
__device__ __forceinline__ XcdBarrier xcd_barrier_post(unsigned* bar, volatile LAS unsigned* st) {
  XcdBarrier b; b.bar = bar; b.x = xb_xcc_id(); b.st = st;
  if (threadIdx.x == 0) (void)xb_add(&bar[XB_XCNT(b.x)], 1u);
  return b;
}
__device__ __forceinline__ void xcd_barrier_complete(unsigned* bar, unsigned x, unsigned& nloc, unsigned& nx) {
  const unsigned G = gridDim.x; unsigned sum, cnt, mine, sp = 0u;
  for (;;) { sum = 0u; cnt = 0u; mine = 0u;
#pragma unroll
    for (unsigned j = 0; j < 16; ++j) { const unsigned c = xb_ld(&bar[XB_XCNT(j)]); sum += c; cnt += (c > 0u) ? 1u : 0u; mine = (j == x) ? c : mine; }
    if (sum == G) break;
    __builtin_amdgcn_s_sleep(1);
    if ((++sp & 255u) == 0u) { if (xb_ld(&bar[XB_TMO])) break; if (sp > XB_SPIN_CAP) { atomicAdd(&bar[XB_TMO], 1u); break; } } }
  nloc = mine > 0u ? mine : 1u; nx = cnt > 0u ? cnt : 1u;
}
__device__ __forceinline__ void xcd_barrier(const XcdBarrier& b) {
  asm volatile("s_waitcnt vmcnt(0)" ::: "memory");
  __syncthreads();
  if (threadIdx.x == 0) {
    unsigned* bar = b.bar;
    __builtin_amdgcn_s_waitcnt(0);
    unsigned nloc = b.st[0], nx = b.st[1];
    if (nloc == 0u) { xcd_barrier_complete(bar, b.x, nloc, nx); b.st[0] = nloc; b.st[1] = nx; }
    const unsigned old = xb_add(&bar[XB_XSUB(b.x)], 1u);
    const unsigned gen = old / nloc;
    if (old + 1u == (gen + 1u) * nloc) {
      __builtin_amdgcn_fence(__ATOMIC_RELEASE, "agent");
      asm volatile("s_waitcnt vmcnt(0)" ::: "memory");
      const unsigned og = xb_add(&bar[XB_TOP], 1u);
      const unsigned tg = og / nx;
      if (og + 1u == (tg + 1u) * nx) xb_add(&bar[XB_TOPGEN], 1u);
      else XB_SPIN(xb_ld(&bar[XB_TOPGEN]) == tg, bar);
      __builtin_amdgcn_fence(__ATOMIC_ACQUIRE, "agent");
      xb_add(&bar[XB_XGEN(b.x)], 1u);
      asm volatile("s_waitcnt vmcnt(0)" ::: "memory");
    } else {
      XB_SPIN(xb_ld(&bar[XB_XGEN(b.x)]) == gen, bar);
      __builtin_amdgcn_fence(__ATOMIC_ACQUIRE, "agent");
      asm volatile("s_waitcnt vmcnt(0)" ::: "memory");
    }
  }
  __syncthreads();
}

constexpr int NPHASE = 9;
constexpr int CW_QUEUE = 0;
constexpr int CW_BAR = 1024;

__global__ void __launch_bounds__(NTHREADS, 2) fwd_kernel(Args a) {
  extern __shared__ __attribute__((aligned(16))) unsigned char lds_raw[];
  LAS unsigned char* lds = (LAS unsigned char*)lds_raw;
  const int tid = threadIdx.x, c = blockIdx.x, G = gridDim.x;
  unsigned char* ws = a.ws; unsigned* ctl = (unsigned*)(ws + O_CTL);
  volatile LAS unsigned* misc = (volatile LAS unsigned*)(lds + LDS_BYTES - 64);
  if (tid < 16) misc[tid] = 0u;
  __syncthreads();
  const bool multi = (a.ph_hi - a.ph_lo) > 1;
  XcdBarrier bar; bar.bar = ctl + CW_BAR; bar.x = 0; bar.st = misc + 8;
  if (multi) bar = xcd_barrier_post(ctl + CW_BAR, misc + 8);
#define IN(k) (a.ph_lo <= (k) && (k) < a.ph_hi)
#define SEAM(k) do { if (IN(k) && IN((k) + 1)) xcd_barrier(bar); } while (0)
  const long NOB = 1L << 30;
  if (IN(0)) { for (int id = c; id < P0A_CHUNKS; id += G) p0a_chunk(id, a, lds); }
  SEAM(0);
  if (IN(1)) {
    if (c < 32) { pg::Gemm g{(const h16*)(ws + O_M16), (const h16*)(ws + O_WKVT), 2048, 2048, 2048, (int)NOB, 0}; pg::OneUnit S{{c >> 4, c & 15}}; pg::EpiHalf E{(h16*)(ws + O_KV16), 4096};
      pg::gemm_phase(lds, g, S, E); }
    else if (c < 64) { const int z = (c - 32) >> 3, pn = (c - 32) & 7;
      pg::Gemm g{(const h16*)(ws + O_WPOOLT) + (size_t)z * 65536, (const h16*)(ws + O_WINZ) + z * 256, 256, 1024, 256, (int)NOB, 0}; pg::OneUnit S{{0, pn}};
      pg::EpiHalf E{(h16*)(ws + O_W1T) + (size_t)(2048 + z * 256) * 2048, 2048}; pg::gemm_phase(lds, g, S, E); }
    else if (c < 128) { const int z = (c - 64) >> 3, pn = (c - 64) & 7;
      pg::Gemm g{(const h16*)(ws + O_SKBD) + (size_t)z * 65536, (const h16*)(ws + O_WQRY) + z * 256, 256, 2048, 256, (int)NOB, 0}; pg::OneUnit S{{0, pn}};
      pg::EpiHalf E{(h16*)(ws + O_WQST) + (size_t)z * 256 * 2048, 2048}; pg::gemm_phase(lds, g, S, E); }
    for (;;) { __syncthreads(); if (tid == 0) misc[0] = atomicAdd(ctl + CW_QUEUE, 1u); __syncthreads(); const int id = (int)misc[0]; if (id >= P0B_CHUNKS) break; p0b_chunk(id, a, lds); }
  }
  SEAM(1);
  if (IN(2)) { pg::Gemm g{(const h16*)(ws + O_RA), (const h16*)(ws + O_W1T), 2048, 2048, 2048, (int)NOB, 0}; pg::StaticOrder S; S.init(64, 12, G, c);
    pg::Epi1 E{(const float*)(ws + O_RSTD1), (h16*)(ws + O_RB), (f32x2*)(ws + O_LNST)};
    pg::gemm_phase(lds, g, S, E); }
  SEAM(2);
  if (IN(3)) {
    if (c < 64) { const int z = c >> 3, pn = c & 7, b = z >> 2, h = z & 3;
      pg::Gemm g{(const h16*)(ws + O_KV16) + (size_t)(b * 256) * 4096 + h * 512, (const h16*)(ws + O_WQ16) + h * 512, 4096, 2048, 512, (int)NOB, 0}; pg::OneUnit S{{0, pn}};
      pg::EpiHalf E{(h16*)(ws + O_WQKT) + (size_t)(b * 1024 + h * 256) * 2048, 2048}; pg::gemm_phase(lds, g, S, E); }
    else if (c < 128) { const int z = (c - 64) >> 3, pm = (c - 64) & 7, b = z >> 2, h = z & 3;
      pg::Gemm g{(const h16*)(ws + O_WOT) + h * 512, (const h16*)(ws + O_KV16) + (size_t)(b * 256) * 4096 + 2048 + h * 512, 2048, 4096, 512, (int)NOB, 0}; pg::OneUnit S{{pm, 0}};
      pg::EpiHalf E{(h16*)(ws + O_WVOT) + (size_t)b * 2048 * 1024 + h * 256, 1024}; pg::gemm_phase(lds, g, S, E); }
    for (int it = c; it < 256; it += G)
      sgu_pool_item(it >> 1, it & 1, (const h16*)(ws + O_RB), (const h16*)(ws + O_RB + 32 * MiB), (const h16*)(ws + O_RB + 64 * MiB), (const f32x2*)(ws + O_LNST), a.in[4], a.in[5],
                    (const h16*)(ws + O_WSGU), a.in[7], (h16*)(ws + O_RA), lds);
  }
  SEAM(3);
  if (IN(4)) { pg::Gemm g{(const h16*)(ws + O_RA), (const h16*)(ws + O_W3T), 2048, 2048, 2048, (int)NOB, 0}; pg::StaticOrder S; S.init(64, 8, G, c);
    pg::EpiRes E{a.in[0], a.out, (h16*)(ws + O_RB), (float*)(ws + O_SSQ2)}; pg::gemm_phase(lds, g, S, E); }
  SEAM(4);
  if (IN(5)) { pg::Gemm g{(const h16*)(ws + O_RB), (const h16*)(ws + O_WQKT), 2048, 2048, 2048, 32, (long)1024 * 2048}; pg::StaticOrder S; S.init(64, 4, G, c);
    pg::EpiSoftmax E{(const float*)(ws + O_SSQ2), (h16*)(ws + O_RB + 64 * MiB)}; pg::gemm_phase(lds, g, S, E); }
  SEAM(5);
  if (IN(6)) { pg::Gemm g{(const h16*)(ws + O_RB + 64 * MiB), (const h16*)(ws + O_WVOT), 1024, 1024, 1024, 32, (long)2048 * 1024}; pg::StaticOrder S; S.init(64, 8, G, c);
    pg::EpiRes E{a.out, a.out, (h16*)(ws + O_RA), (float*)(ws + O_SSQ3)}; pg::gemm_phase(lds, g, S, E); }
  SEAM(6);
  if (IN(7)) { pg::Gemm g{(const h16*)(ws + O_RA), (const h16*)(ws + O_WQST), 2048, 2048, 2048, (int)NOB, 0}; pg::StaticOrder S; S.init(64, 8, G, c);
    pg::EpiScore E{(const float*)(ws + O_SSQ3), (float*)(ws + O_RB)}; pg::gemm_phase(lds, g, S, E); }
  SEAM(7);
  if (IN(8)) {
    peer_topk((const float*)(ws + O_RB), (const float*)(ws + O_SU), (const float*)(ws + O_SV), 64 * c, lds);
    const int wid = tid >> 6;
    peer_gather_wave(a.out, ws + O_U8, ws + O_V8, a.in[16], a.in[21], 64 * c + 8 * wid, 8 * wid, 8, lds);
  }
#undef IN
#undef SEAM
}
#ifndef HYBRID_CUT
#define HYBRID_CUT 9
#endif
#ifndef ONE_LAUNCH
#define ONE_LAUNCH 0
#endif

#if HYBRID_CUT < 9
static void slow_xattn(hipStream_t stream, void* const* d_in, float* h, float* ws) {
  const float* mem = (const float*)d_in[1]; const float* g_xattn = (const float*)d_in[11]; const float* g_mem = (const float*)d_in[12]; const float* w_q = (const float*)d_in[13]; const float* w_kv = (const float*)d_in[14]; const float* w_o = (const float*)d_in[15];
  float* R0 = ws; float* R1 = R0 + (size_t)TT * 3072; float* S0 = R1 + (size_t)TT * 2048; float* mnorm = S0; float* kv = S0 + (size_t)512 * 2048;
  hipLaunchKernelGGL(k_rmsnorm, dim3(TT), dim3(256), 0, stream, (const float*)h, g_xattn, R1);
  hipLaunchKernelGGL(k_rmsnorm, dim3(512), dim3(256), 0, stream, mem, g_mem, mnorm);
  gemm(stream, mnorm, 2048, w_kv, 4096, 0, kv, 4096, nullptr, 512, 4096, 2048);
  float* q = R0; float* sc = R0 + (size_t)TT * 2048;
  gemm(stream, R1, 2048, w_q, 2048, 0, q, 2048, nullptr, TT, 2048, 2048);
  gemm(stream, q, 2048, kv, 4096, 1, sc, 256, nullptr, SEQ, 256, 512, 8, 4, (long)SEQ * 2048, 512, (long)256 * 4096, 512, (long)4 * SEQ * 256, (long)SEQ * 256);
  hipLaunchKernelGGL(k_softmax256, dim3(8 * SEQ / 4), dim3(256), 0, stream, sc, 0.044194173824159216f);
  gemm(stream, sc, 256, kv + 2048, 4096, 0, R1, 2048, nullptr, SEQ, 512, 256, 8, 4, (long)4 * SEQ * 256, (long)SEQ * 256, (long)256 * 4096, 512, (long)SEQ * 2048, 512);
  gemm(stream, R1, 2048, w_o, 2048, 0, h, 2048, h, TT, 2048, 2048);
}
static void slow_peer(hipStream_t stream, void* const* d_in, float* h, float* ws, float* out) {
  const float* g_peer = (const float*)d_in[16]; const float* w_query = (const float*)d_in[17]; const float* sub_keys = (const float*)d_in[18]; const float* peer_u = (const float*)d_in[19]; const float* peer_v = (const float*)d_in[20]; const float* g_final = (const float*)d_in[21];
  float* R0 = ws; float* R1 = R0 + (size_t)TT * 3072; float* S0 = R1 + (size_t)TT * 2048;
  int* idx = (int*)(S0 + (size_t)TT * 1024); float* gates = S0 + (size_t)TT * 1024 + (size_t)TT * 128;
  hipLaunchKernelGGL(k_rmsnorm, dim3(TT), dim3(256), 0, stream, (const float*)h, g_peer, R1);
  float* pq = R0; float* pscore = R1;
  gemm(stream, R1, 2048, w_query, 2048, 0, pq, 2048, nullptr, TT, 2048, 2048);
  gemm(stream, pq, 2048, sub_keys, 128, 1, pscore, 2048, nullptr, TT, 128, 128, 16, 1, 128, 0, 16384, 0, 128, 0);
  hipLaunchKernelGGL(k_topk, dim3(TT * 8 / 4), dim3(256), 0, stream, (const float*)pscore, idx, gates);
  hipLaunchKernelGGL(k_experts, dim3(TT / 4), dim3(256), 0, stream, g_peer, (const float*)h, (const int*)idx, (const float*)gates, peer_u, peer_v, g_final, out);
}
#endif

extern "C" void kernel_launch(void* const* d_in, const int* in_sizes, int n_in, void* d_out, int out_size, void* d_ws, size_t ws_size, hipStream_t stream) {
  static int grid = 0;
  if (grid == 0) {
    if (n_in != 22 || out_size != T_ * D_ || ws_size < WS_END) { fprintf(stderr, "kernel_launch: unexpected problem shape (n_in %d out %d ws %zu need %zu)\n", n_in, out_size, ws_size, (size_t)WS_END); grid = -1; return; }
    int dev = 0, cus = 0, per_cu = 0;
    (void)hipGetDevice(&dev); (void)hipDeviceGetAttribute(&cus, hipDeviceAttributeMultiprocessorCount, dev);
    if (hipFuncSetAttribute((const void*)fwd_kernel, hipFuncAttributeMaxDynamicSharedMemorySize, LDS_BYTES) != hipSuccess) { fprintf(stderr, "kernel_launch: hipFuncSetAttribute failed\n"); grid = -1; return; }
    (void)hipOccupancyMaxActiveBlocksPerMultiprocessor(&per_cu, (const void*)fwd_kernel, NTHREADS, LDS_BYTES);
    (void)hipGetLastError();
    if (cus != 256 || per_cu < 1) { fprintf(stderr, "kernel_launch: needs a 256-CU device with one resident workgroup per CU (cus %d, per_cu %d)\n", cus, per_cu); grid = -1; return; }
    grid = 256;
  }
  if (grid < 0) return;
  (void)hipMemsetAsync((char*)d_ws + O_CTL, 0, CTL_BYTES, stream);
  Args a{};
  for (int i = 0; i < 22; ++i) a.in[i] = (const float*)d_in[i];
  a.out = (float*)d_out; a.ws = (unsigned char*)d_ws;
#if ONE_LAUNCH
  a.ph_lo = 0; a.ph_hi = HYBRID_CUT;
  hipLaunchKernelGGL(fwd_kernel, dim3(grid), dim3(NTHREADS), LDS_BYTES, stream, a);
#else
  for (int p = 0; p < HYBRID_CUT; ++p) { a.ph_lo = p; a.ph_hi = p + 1; hipLaunchKernelGGL(fwd_kernel, dim3(grid), dim3(NTHREADS), LDS_BYTES, stream, a); }
#endif
#if HYBRID_CUT < 9
  float* h = (float*)d_out;
  if (HYBRID_CUT <= 5) slow_xattn(stream, d_in, h, (float*)d_ws);
  slow_peer(stream, d_in, h, (float*)d_ws, (float*)d_out);
#endif
}
```

```cpp
#define HYBRID_CUT 9
#define ONE_LAUNCH 1
#include <hip/hip_runtime.h>
#include <cstdio>
#include <math.h>

#define LAS __attribute__((address_space(3)))
typedef _Float16 h16;
typedef _Float16 half8 __attribute__((ext_vector_type(8)));
typedef _Float16 half4 __attribute__((ext_vector_type(4)));
typedef _Float16 half2v __attribute__((ext_vector_type(2)));
typedef float f32x4 __attribute__((ext_vector_type(4)));
typedef float f32x2 __attribute__((ext_vector_type(2)));
typedef unsigned u32x4 __attribute__((ext_vector_type(4)));
typedef unsigned u32x2 __attribute__((ext_vector_type(2)));

constexpr int T_ = 16384, D_ = 2048, SEQ_ = 8192;
constexpr float EPS_ = 1e-6f;
constexpr size_t MiB = 1ull << 20;
constexpr size_t O_W1T   = 0;
constexpr size_t O_W3T   = O_W1T   + 12 * MiB;
constexpr size_t O_WKVT  = O_W3T   + 8 * MiB;
constexpr size_t O_WQ16  = O_WKVT  + 16 * MiB;
constexpr size_t O_WOT   = O_WQ16  + 8 * MiB;
constexpr size_t O_WQRY  = O_WOT   + 8 * MiB;
constexpr size_t O_WQST  = O_WQRY  + 8 * MiB;
constexpr size_t O_WQKT  = O_WQST  + 8 * MiB;
constexpr size_t O_WVOT  = O_WQKT  + 8 * MiB;
constexpr size_t O_WINZ  = O_WVOT  + 8 * MiB;
constexpr size_t O_WPOOLT= O_WINZ  + 4 * MiB;
constexpr size_t O_SKBD  = O_WPOOLT+ 1 * MiB;
constexpr size_t O_WSGU  = O_SKBD  + 1 * MiB;
constexpr size_t O_M16   = O_WSGU  + 1 * MiB;
constexpr size_t O_KV16  = O_M16   + 2 * MiB;
constexpr size_t O_U8    = O_KV16  + 4 * MiB;
constexpr size_t O_V8    = O_U8    + 32 * MiB;
constexpr size_t O_SU    = O_V8    + 32 * MiB;
constexpr size_t O_SV    = O_SU    + 1 * MiB;
constexpr size_t O_RSTD1 = O_SV    + 1 * MiB;
constexpr size_t O_LNST  = O_RSTD1 + 1 * MiB;
constexpr size_t O_SSQ2  = O_LNST  + 2 * MiB;
constexpr size_t O_SSQ3  = O_SSQ2  + 2 * MiB;
constexpr size_t O_CTL   = O_SSQ3  + 2 * MiB;
constexpr size_t O_X16   = O_CTL   + 1 * MiB;
constexpr size_t O_RA    = O_X16   + 64 * MiB;
constexpr size_t O_RB    = O_RA    + 64 * MiB;
constexpr size_t WS_END  = O_RB    + 128 * MiB;
constexpr size_t CTL_BYTES = 64 * 1024;

constexpr int LDS_BYTES = 144 * 1024;
constexpr int NTHREADS = 512;

__device__ __forceinline__ float wave_sum(float v) {
  v += __builtin_bit_cast(float, __builtin_amdgcn_update_dpp(0, __builtin_bit_cast(int, v), 0xB1, 0xf, 0xf, true));
  v += __builtin_bit_cast(float, __builtin_amdgcn_update_dpp(0, __builtin_bit_cast(int, v), 0x4E, 0xf, 0xf, true));
  v += __builtin_bit_cast(float, __builtin_amdgcn_update_dpp(0, __builtin_bit_cast(int, v), 0x141, 0xf, 0xf, true));
  v += __builtin_bit_cast(float, __builtin_amdgcn_update_dpp(0, __builtin_bit_cast(int, v), 0x140, 0xf, 0xf, true));
  v += __builtin_bit_cast(float, __builtin_amdgcn_update_dpp(0, __builtin_bit_cast(int, v), 0x142, 0xa, 0xf, false));
  v += __builtin_bit_cast(float, __builtin_amdgcn_update_dpp(0, __builtin_bit_cast(int, v), 0x143, 0xc, 0xf, false));
  return __builtin_bit_cast(float, __builtin_amdgcn_readlane(__builtin_bit_cast(int, v), 63));
}
__device__ __forceinline__ float wave_max(float v) {
  for (int o = 32; o >= 1; o >>= 1) v = fmaxf(v, __shfl_xor(v, o));
  return v;
}
__device__ __forceinline__ unsigned pk_h2(float lo, float hi) { half2v r; r.x = (h16)lo; r.y = (h16)hi; return __builtin_bit_cast(unsigned, r); }
__device__ __forceinline__ float gelu_f(float v) { return 0.5f * v * (1.0f + erff(v * 0.70710678118654752f)); }
__device__ __forceinline__ f32x2 gelu_pk(f32x2 v) {
    const f32x2 av = __builtin_elementwise_abs(v), d = av * 0.2316418882f + 1.0f;
    f32x2 t; t.x = __builtin_amdgcn_rcpf(d.x); t.y = __builtin_amdgcn_rcpf(d.y);
    f32x2 q = t * 0.5307027145f + (-0.7265760135f); q = q * t + 0.7107068705f; q = q * t + (-0.142248368f); q = q * t + 0.127414796f; q = q * t;
    const f32x2 s = (v * v) * (-0.72134752044f);
    f32x2 e; e.x = __builtin_amdgcn_exp2f(s.x); e.y = __builtin_amdgcn_exp2f(s.y);
    const f32x2 m = v * (q * e), r = v - m;
    f32x2 o; o.x = v.x < 0.f ? m.x : r.x; o.y = v.y < 0.f ? m.y : r.y; return o;
}
namespace pg {
constexpr int BM = 256, BK = 64, HALF = 128, HTB = HALF * BK * 2, STAGE_BYTES = 8 * HTB, NXCD = 8, WGM = 8;

__host__ __device__ __forceinline__ int lds_byte(int r, int c) { const int st = (r >> 4) * 2 + (c >> 5), rr = r & 15, cc = c & 31, ob = rr * 64 + cc * 2; return st * 1024 + (ob ^ (((ob >> 9) & 1) << 5)); }
__host__ __device__ __forceinline__ void stage_rc(int b, int& R, int& C) { const int st = b / 1024, sb = b % 1024, swz = sb ^ (((sb >> 9) & 1) << 5); R = (st >> 1) * 16 + swz / 64; C = (st & 1) * 32 + (swz % 64) / 2; }
__host__ __device__ __forceinline__ int perm32(int rho) { const int n = rho >> 4, i = rho & 15; return 8 * (i >> 2) + 4 * n + (i & 3); }

struct Unit { int pm, pn; };
struct Gemm { const h16* A; const h16* Bt; int lda, ldb, K, bdiv; long bstride; };

struct StaticOrder {
    int nM, nN, nwg, G, c;
    __device__ void init(int nM_, int nN_, int G_, int c_) { nM = nM_; nN = nN_; nwg = nM * nN; G = G_; c = c_; }
    __device__ bool next(int i, Unit& u) const {
        const long L = (long)i * G + c; if (L >= nwg) return false;
        int wgid = (int)L; { const int q = nwg / NXCD, r = nwg % NXCD, xcd = wgid % NXCD, off = wgid / NXCD; wgid = (xcd < r ? xcd * (q + 1) : r * (q + 1) + (xcd - r) * q) + off; }
        const int nig = WGM * nN, gid = wgid / nig, fm = gid * WGM, gsz = (nM - fm) < WGM ? (nM - fm) : WGM;
        u.pm = fm + ((wgid % nig) % gsz); u.pn = (wgid % nig) / gsz; return true;
    }
};
struct OneUnit { Unit u; __device__ bool next(int i, Unit& o) const { if (i != 0) return false; o = u; return true; } };

typedef f32x4 Acc[2][2][4][2];

template <class Epi, class Sched, bool ALIGN_EPI = true, bool SP2 = true>
__device__ __forceinline__ void gemm_phase(LAS unsigned char* lds, const Gemm g, const Sched& S, const Epi& E) {
    const int tid = threadIdx.x, wid = __builtin_amdgcn_readfirstlane(tid >> 6), lane = tid & 63, wr = wid >> 2, wc = wid & 3, fr = lane & 15, fq = lane >> 4;
    const int K = g.K, nt = K / BK;
    unsigned voffA[2], voffB[2];
#pragma unroll
    for (int i = 0; i < 2; ++i) { int R, C; stage_rc(tid * 16 + i * 8192, R, C); const int Rb = Epi::PERM ? ((R & ~31) + perm32(R & 31)) : R;
        voffA[i] = (unsigned)(R * g.lda + C) * 2u; voffB[i] = (unsigned)(Rb * g.ldb + C) * 2u; }
    const size_t kstep = (size_t)(BK * 2);
    const size_t hstepA = (size_t)HALF * g.lda * 2, hstepB = (size_t)HALF * g.ldb * 2;
    const size_t tstepA = 2 * hstepA, tstepB = 2 * hstepB;
    const unsigned ldsw = (unsigned)wid * 1024u;
    const int aoff = lds_byte(wr * 64 + fr, fq * 8), boff = lds_byte(wc * 32 + fr, fq * 8);
#define PG_SA(b, h) (((b) * 2 + (h)) * HTB)
#define PG_SB(b, h) ((4 + (b) * 2 + (h)) * HTB)
#define PG_STAGE(bufoff, gbase, voff) do { _Pragma("unroll") for (int _i = 0; _i < 2; ++_i) \
        __builtin_amdgcn_global_load_lds((const unsigned*)((const char*)(gbase) + (voff)[_i]), (LAS unsigned*)(lds + (bufoff) + ldsw + _i * 8192), 16, 0, 0); } while (0)
#define PG_LDA(dst, b, h) do { _Pragma("unroll") for (int m = 0; m < 4; ++m) _Pragma("unroll") for (int k = 0; k < 2; ++k) dst[m][k] = *(const LAS half8*)(lds + PG_SA(b, h) + aoff + m * 2048 + k * 1024); } while (0)
#define PG_LDB(dst, b, h) do { _Pragma("unroll") for (int n = 0; n < 2; ++n) _Pragma("unroll") for (int k = 0; k < 2; ++k) dst[n][k] = *(const LAS half8*)(lds + PG_SB(b, h) + boff + n * 2048 + k * 1024); } while (0)
#define PG_MMA(ai, bj, At, Bt) do { __builtin_amdgcn_s_setprio(1); _Pragma("unroll") for (int m = 0; m < 4; ++m) _Pragma("unroll") for (int n = 0; n < 2; ++n) _Pragma("unroll") for (int k = 0; k < 2; ++k) \
        acc[ai][bj][m][n] = __builtin_amdgcn_mfma_f32_16x16x32_f16(Bt[n][k], At[m][k], acc[ai][bj][m][n], 0, 0, 0); __builtin_amdgcn_s_setprio(0); } while (0)
#define PG_WAIT_V(n) asm volatile("s_waitcnt vmcnt(" #n ")" ::: "memory")
#define PG_WAIT_L(n) asm volatile("s_waitcnt lgkmcnt(" #n ")" ::: "memory")
#define PG_BAR __builtin_amdgcn_s_barrier()
#define PG_SCHED __builtin_amdgcn_sched_barrier(0)
    Unit cur, nxt; int ui = 0;
    if (!S.next(0, cur)) return;
    f32x4 acc[2][2][4][2];
#pragma unroll
    for (int a = 0; a < 2; ++a)
#pragma unroll
        for (int b = 0; b < 2; ++b)
#pragma unroll
            for (int m = 0; m < 4; ++m)
#pragma unroll
                for (int n = 0; n < 2; ++n) acc[a][b][m][n] = (f32x4){0.f, 0.f, 0.f, 0.f};
    half8 At[4][2], B0[2][2], B1[2][2];
    const char* cA = (const char*)g.A + (size_t)cur.pm * tstepA;
    const char* cB = (const char*)(g.Bt + (size_t)(cur.pm / g.bdiv) * g.bstride) + (size_t)cur.pn * tstepB;
    if constexpr (SP2) {
        PG_STAGE(PG_SB(0, 0), cB, voffB); PG_STAGE(PG_SB(0, 1), cB + hstepB, voffB); PG_STAGE(PG_SA(0, 0), cA, voffA); PG_STAGE(PG_SA(0, 1), cA + hstepA, voffA);
        if (wr == 1) PG_BAR;
        PG_WAIT_V(2); PG_BAR;
        PG_STAGE(PG_SB(1, 0), cB + kstep, voffB); PG_STAGE(PG_SA(1, 0), cA + kstep, voffA); PG_STAGE(PG_SB(1, 1), cB + hstepB + kstep, voffB);
        PG_WAIT_V(6); PG_BAR;
    } else {
        PG_STAGE(PG_SB(0, 0), cB, voffB); PG_STAGE(PG_SA(0, 0), cA, voffA); PG_STAGE(PG_SB(0, 1), cB + hstepB, voffB); PG_STAGE(PG_SA(0, 1), cA + hstepA, voffA);
        if (wr == 1) PG_BAR;
        PG_WAIT_V(4); PG_BAR;
        PG_STAGE(PG_SB(1, 0), cB + kstep, voffB); PG_STAGE(PG_SA(1, 0), cA + kstep, voffA); PG_STAGE(PG_SB(1, 1), cB + hstepB + kstep, voffB);
        PG_WAIT_V(6); PG_BAR;
    }
    for (;;) {
        const bool has_next = S.next(ui + 1, nxt);
        const char* nA = has_next ? (const char*)g.A + (size_t)nxt.pm * tstepA : cA;
        const char* nB = has_next ? (const char*)(g.Bt + (size_t)(nxt.pm / g.bdiv) * g.bstride) + (size_t)nxt.pn * tstepB : cB;
        for (int t = 0; t < nt; t += 2) {
            const bool last = (t == nt - 2);
            const char* a1 = cA + (size_t)(t + 1) * kstep;
            const char* a2 = last ? nA : cA + (size_t)(t + 2) * kstep; const char* b2 = last ? nB : cB + (size_t)(t + 2) * kstep;
            const char* a3 = a2 + kstep; const char* b3 = b2 + kstep;
            if constexpr (SP2) {
            PG_LDB(B0, 0, 0); PG_LDB(B1, 0, 1); PG_SCHED; PG_LDA(At, 0, 0); PG_STAGE(PG_SA(1, 1), a1 + hstepA, voffA);
            PG_WAIT_V(8); PG_WAIT_L(0); PG_BAR; PG_MMA(0, 0, At, B0); PG_MMA(0, 1, At, B1); PG_BAR; PG_SCHED;
            PG_LDA(At, 0, 1); PG_STAGE(PG_SB(0, 0), b2, voffB); PG_STAGE(PG_SB(0, 1), b2 + hstepB, voffB); PG_STAGE(PG_SA(0, 0), a2, voffA);
            PG_WAIT_V(8); PG_WAIT_L(0); PG_BAR; PG_MMA(1, 0, At, B0); PG_MMA(1, 1, At, B1); PG_BAR; PG_SCHED;
            PG_LDB(B0, 1, 0); PG_LDB(B1, 1, 1); PG_SCHED; PG_LDA(At, 1, 0); PG_STAGE(PG_SA(0, 1), a2 + hstepA, voffA);
            PG_WAIT_V(8); PG_WAIT_L(0); PG_BAR; PG_MMA(0, 0, At, B0); PG_MMA(0, 1, At, B1); PG_BAR; PG_SCHED;
            PG_LDA(At, 1, 1); PG_STAGE(PG_SB(1, 0), b3, voffB); PG_STAGE(PG_SB(1, 1), b3 + hstepB, voffB); PG_STAGE(PG_SA(1, 0), a3, voffA);
            PG_WAIT_V(8); PG_WAIT_L(0); PG_BAR; PG_MMA(1, 0, At, B0); PG_MMA(1, 1, At, B1); PG_BAR; PG_SCHED;
            } else {
            PG_LDB(B0, 0, 0); PG_SCHED; PG_LDA(At, 0, 0); PG_STAGE(PG_SA(1, 1), a1 + hstepA, voffA);
            PG_WAIT_L(8); PG_BAR; PG_WAIT_L(0); PG_MMA(0, 0, At, B0); PG_BAR; PG_SCHED;
            PG_LDB(B1, 0, 1); PG_STAGE(PG_SB(0, 0), b2, voffB);
            PG_BAR; PG_WAIT_L(0); PG_MMA(0, 1, At, B1); PG_BAR;
            PG_LDA(At, 0, 1); PG_STAGE(PG_SA(0, 0), a2, voffA);
            PG_BAR; PG_WAIT_L(0); PG_MMA(1, 0, At, B0); PG_BAR; PG_SCHED;
            PG_STAGE(PG_SB(0, 1), b2 + hstepB, voffB);
            PG_WAIT_V(6); PG_BAR; PG_MMA(1, 1, At, B1); PG_BAR;
            PG_LDB(B0, 1, 0); PG_SCHED; PG_LDA(At, 1, 0); PG_STAGE(PG_SA(0, 1), a2 + hstepA, voffA);
            PG_WAIT_L(8); PG_BAR; PG_WAIT_L(0); PG_MMA(0, 0, At, B0); PG_BAR; PG_SCHED;
            PG_LDB(B1, 1, 1); PG_STAGE(PG_SB(1, 0), b3, voffB);
            PG_BAR; PG_WAIT_L(0); PG_MMA(0, 1, At, B1); PG_BAR;
            PG_LDA(At, 1, 1); PG_STAGE(PG_SA(1, 0), a3, voffA);
            PG_BAR; PG_WAIT_L(0); PG_MMA(1, 0, At, B0); PG_BAR; PG_SCHED;
            PG_STAGE(PG_SB(1, 1), b3 + hstepB, voffB);
            PG_WAIT_V(6); PG_BAR; PG_MMA(1, 1, At, B1); PG_BAR;
                    }
        }
        if constexpr (ALIGN_EPI) { if (wr == 0) PG_BAR; }
        if constexpr (!Epi::AFTER_DRAIN) { E(acc, cur, wr, wc, fr, fq, lds + STAGE_BYTES); }
        if (!has_next) break;
#pragma unroll
        for (int a = 0; a < 2; ++a)
#pragma unroll
            for (int b = 0; b < 2; ++b)
#pragma unroll
                for (int m = 0; m < 4; ++m)
#pragma unroll
                    for (int n = 0; n < 2; ++n) acc[a][b][m][n] = (f32x4){0.f, 0.f, 0.f, 0.f};
        cur = nxt; cA = nA; cB = nB; ++ui;
        if constexpr (ALIGN_EPI) { if (wr == 1) PG_BAR; }
    }
    PG_WAIT_V(0);
    if constexpr (!ALIGN_EPI) { if (wr == 0) PG_BAR; }
    PG_BAR;
    if constexpr (Epi::AFTER_DRAIN) { E.fused(acc, cur, wr, wc, fr, fq, lds); }
#undef PG_SA
#undef PG_SB
#undef PG_STAGE
#undef PG_LDA
#undef PG_LDB
#undef PG_MMA
#undef PG_WAIT_V
#undef PG_WAIT_L
#undef PG_BAR
#undef PG_SCHED
}
}
namespace pg {
struct EpiHalf {
    static constexpr bool PERM = true, AFTER_DRAIN = false;
    h16* O; int ldc;
    __device__ __forceinline__ void operator()(const Acc& acc, const Unit& u, int wr, int wc, int fr, int fq, LAS unsigned char*) const {
        const int row0 = u.pm * BM + wr * 64 + fr, col0 = u.pn * BM + wc * 32 + 8 * fq;
#pragma unroll
        for (int ai = 0; ai < 2; ++ai)
#pragma unroll
            for (int m = 0; m < 4; ++m) { h16* rowp = O + (size_t)(row0 + ai * HALF + m * 16) * ldc + col0;
#pragma unroll
                for (int bj = 0; bj < 2; ++bj) { const f32x4 v0 = acc[ai][bj][m][0], v1 = acc[ai][bj][m][1];
                    u32x4 w; w.x = pk_h2(v0[0], v0[1]); w.y = pk_h2(v0[2], v0[3]); w.z = pk_h2(v1[0], v1[1]); w.w = pk_h2(v1[2], v1[3]);
                    *(u32x4*)(rowp + bj * HALF) = w; } }
    }
};
struct Epi1 {
    static constexpr bool PERM = true, AFTER_DRAIN = false;
    const float* rstd1; h16* UVZ; f32x2* lnst;
    __device__ __forceinline__ void operator()(const Acc& acc, const Unit& u, int wr, int wc, int fr, int fq, LAS unsigned char*) const {
        const int seg = u.pn >> 2, pnl = u.pn & 3;
        h16* base = UVZ + (size_t)seg * (16u << 20);
        const int row0 = u.pm * BM + wr * 64 + fr, col0 = pnl * BM + wc * 32 + 8 * fq;
#pragma unroll
        for (int ai = 0; ai < 2; ++ai)
#pragma unroll
            for (int m = 0; m < 4; ++m) { const int row = row0 + ai * HALF + m * 16; const float rs = rstd1[row]; h16* rowp = base + (size_t)row * 1024 + col0;
                float s = 0.f, ss = 0.f;
#pragma unroll
                for (int bj = 0; bj < 2; ++bj) { f32x4 v0 = acc[ai][bj][m][0] * rs, v1 = acc[ai][bj][m][1] * rs;
                    if (seg < 2) { f32x2 a = gelu_pk((f32x2){v0[0], v0[1]}), b = gelu_pk((f32x2){v0[2], v0[3]}), c = gelu_pk((f32x2){v1[0], v1[1]}), d = gelu_pk((f32x2){v1[2], v1[3]});
                        v0 = (f32x4){a.x, a.y, b.x, b.y}; v1 = (f32x4){c.x, c.y, d.x, d.y}; }
                    if (seg == 1) { s += (v0[0] + v0[1]) + (v0[2] + v0[3]) + (v1[0] + v1[1]) + (v1[2] + v1[3]);
                        ss += (v0[0] * v0[0] + v0[1] * v0[1]) + (v0[2] * v0[2] + v0[3] * v0[3]) + (v1[0] * v1[0] + v1[1] * v1[1]) + (v1[2] * v1[2] + v1[3] * v1[3]); }
                    u32x4 w; w.x = pk_h2(v0[0], v0[1]); w.y = pk_h2(v0[2], v0[3]); w.z = pk_h2(v1[0], v1[1]); w.w = pk_h2(v1[2], v1[3]);
                    *(u32x4*)(rowp + bj * HALF) = w; }
                if (seg == 1) { s += __shfl_xor(s, 16); s += __shfl_xor(s, 32); ss += __shfl_xor(ss, 16); ss += __shfl_xor(ss, 32);
                    if (fq == 0) lnst[(size_t)row * 16 + pnl * 4 + wc] = (f32x2){s, ss}; } }
    }
};
struct EpiRes {
    static constexpr bool PERM = true, AFTER_DRAIN = false;
    const h16* res; h16* o16; float* ssq;
    __device__ __forceinline__ void operator()(const Acc& acc, const Unit& u, int wr, int wc, int fr, int fq, LAS unsigned char*) const {
        const int row0 = u.pm * BM + wr * 64 + fr, col0 = u.pn * BM + wc * 32 + 8 * fq;
        half8 r[2][4][2];
#pragma unroll
        for (int ai = 0; ai < 2; ++ai)
#pragma unroll
            for (int m = 0; m < 4; ++m)
#pragma unroll
                for (int bj = 0; bj < 2; ++bj) r[ai][m][bj] = *(const half8*)(res + (size_t)(row0 + ai * HALF + m * 16) * 2048 + col0 + bj * HALF);
#pragma unroll
        for (int ai = 0; ai < 2; ++ai)
#pragma unroll
            for (int m = 0; m < 4; ++m) { const int row = row0 + ai * HALF + m * 16; const size_t off = (size_t)row * 2048 + col0; float q = 0.f;
#pragma unroll
                for (int bj = 0; bj < 2; ++bj) { const half8 rr = r[ai][m][bj];
                    const f32x4 v0 = acc[ai][bj][m][0] + (f32x4){(float)rr[0], (float)rr[1], (float)rr[2], (float)rr[3]}, v1 = acc[ai][bj][m][1] + (f32x4){(float)rr[4], (float)rr[5], (float)rr[6], (float)rr[7]};
                    u32x4 w; w.x = pk_h2(v0[0], v0[1]); w.y = pk_h2(v0[2], v0[3]); w.z = pk_h2(v1[0], v1[1]); w.w = pk_h2(v1[2], v1[3]);
                    *(u32x4*)(o16 + off + bj * HALF) = w;
                    q += (v0[0] * v0[0] + v0[1] * v0[1]) + (v0[2] * v0[2] + v0[3] * v0[3]) + (v1[0] * v1[0] + v1[1] * v1[1]) + (v1[2] * v1[2] + v1[3] * v1[3]); }
                q += __shfl_xor(q, 16); q += __shfl_xor(q, 32);
                if (fq == 0) ssq[(size_t)row * 32 + u.pn * 4 + wc] = q; }
    }
};
__device__ __forceinline__ void rows_rstd(const float* ssq, int row0, int fq, float (&rs)[2][4]) {
    f32x4 a[2][4], b[2][4];
#pragma unroll
    for (int ai = 0; ai < 2; ++ai)
#pragma unroll
        for (int m = 0; m < 4; ++m) { const float* p = ssq + (size_t)(row0 + ai * HALF + m * 16) * 32 + fq * 8; a[ai][m] = *(const f32x4*)p; b[ai][m] = *(const f32x4*)(p + 4); }
#pragma unroll
    for (int ai = 0; ai < 2; ++ai)
#pragma unroll
        for (int m = 0; m < 4; ++m) { float q = ((a[ai][m][0] + a[ai][m][1]) + (a[ai][m][2] + a[ai][m][3])) + ((b[ai][m][0] + b[ai][m][1]) + (b[ai][m][2] + b[ai][m][3]));
            q += __shfl_xor(q, 16); q += __shfl_xor(q, 32); rs[ai][m] = rsqrtf(q * (1.0f / 2048.0f) + EPS_); }
}
__device__ __forceinline__ float row_rstd(const float* ssq, int row, int fq) {
    const float* p = ssq + (size_t)row * 32 + fq * 8; const f32x4 a = *(const f32x4*)p, b = *(const f32x4*)(p + 4);
    float q = ((a[0] + a[1]) + (a[2] + a[3])) + ((b[0] + b[1]) + (b[2] + b[3]));
    q += __shfl_xor(q, 16); q += __shfl_xor(q, 32);
    return rsqrtf(q * (1.0f / 2048.0f) + EPS_);
}
struct EpiSoftmax {
    static constexpr bool PERM = true, AFTER_DRAIN = true;
    const float* ssq2; h16* P;
    __device__ __forceinline__ void fused(Acc& acc, const Unit& u, int wr, int wc, int fr, int fq, LAS unsigned char* lds) const {
        LAS f32x2* X = (LAS f32x2*)lds;
        float mxs[2][4], rsv[2][4];
        rows_rstd(ssq2, u.pm * BM + wr * 64 + fr, fq, rsv);
#pragma unroll
        for (int ai = 0; ai < 2; ++ai)
#pragma unroll
            for (int m = 0; m < 4; ++m) { const int rl = ai * HALF + wr * 64 + m * 16 + fr;
                const float rs = rsv[ai][m] * 0.044194173824159216f;
                float mx = -INFINITY;
#pragma unroll
                for (int bj = 0; bj < 2; ++bj)
#pragma unroll
                    for (int n = 0; n < 2; ++n) { f32x4 v = acc[ai][bj][m][n] * rs; acc[ai][bj][m][n] = v; mx = fmaxf(mx, fmaxf(fmaxf(v[0], v[1]), fmaxf(v[2], v[3]))); }
                mx = fmaxf(mx, __shfl_xor(mx, 16)); mx = fmaxf(mx, __shfl_xor(mx, 32));
                float l = 0.f;
#pragma unroll
                for (int bj = 0; bj < 2; ++bj)
#pragma unroll
                    for (int n = 0; n < 2; ++n) { f32x4 v = acc[ai][bj][m][n]; v[0] = __expf(v[0] - mx); v[1] = __expf(v[1] - mx); v[2] = __expf(v[2] - mx); v[3] = __expf(v[3] - mx);
                        acc[ai][bj][m][n] = v; l += (v[0] + v[1]) + (v[2] + v[3]); }
                l += __shfl_xor(l, 16); l += __shfl_xor(l, 32);
                if (fq == 0) X[rl * 4 + wc] = (f32x2){mx, l};
                mxs[ai][m] = mx; }
        asm volatile("s_waitcnt lgkmcnt(0)" ::: "memory"); __builtin_amdgcn_s_barrier(); asm volatile("" ::: "memory");
        const int col0 = u.pn * BM + wc * 32 + 8 * fq;
#pragma unroll
        for (int ai = 0; ai < 2; ++ai)
#pragma unroll
            for (int m = 0; m < 4; ++m) { const int rl = ai * HALF + wr * 64 + m * 16 + fr; const int row = u.pm * BM + rl;
                const f32x2 x0 = X[rl * 4 + 0], x1 = X[rl * 4 + 1], x2 = X[rl * 4 + 2], x3 = X[rl * 4 + 3];
                const float M = fmaxf(fmaxf(x0.x, x1.x), fmaxf(x2.x, x3.x));
                const float L = x0.y * __expf(x0.x - M) + x1.y * __expf(x1.x - M) + x2.y * __expf(x2.x - M) + x3.y * __expf(x3.x - M);
                const float f = __expf(mxs[ai][m] - M) / L;
                h16* rowp = P + (size_t)row * 1024 + col0;
#pragma unroll
                for (int bj = 0; bj < 2; ++bj) { const f32x4 v0 = acc[ai][bj][m][0] * f, v1 = acc[ai][bj][m][1] * f;
                    u32x4 w; w.x = pk_h2(v0[0], v0[1]); w.y = pk_h2(v0[2], v0[3]); w.z = pk_h2(v1[0], v1[1]); w.w = pk_h2(v1[2], v1[3]);
                    *(u32x4*)(rowp + bj * HALF) = w; } }
    }
};
struct EpiScore {
    static constexpr bool PERM = false, AFTER_DRAIN = false;
    const float* ssq3; float* S;
    __device__ __forceinline__ void operator()(const Acc& acc, const Unit& u, int wr, int wc, int fr, int fq, LAS unsigned char*) const {
        const int row0 = u.pm * BM + wr * 64 + fr, col0 = u.pn * BM + wc * 32 + 4 * fq;
        float rsv[2][4]; rows_rstd(ssq3, row0, fq, rsv);
#pragma unroll
        for (int ai = 0; ai < 2; ++ai)
#pragma unroll
            for (int m = 0; m < 4; ++m) { const int row = row0 + ai * HALF + m * 16; const float rs = rsv[ai][m]; float* rowp = S + (size_t)row * 2048 + col0;
#pragma unroll
                for (int bj = 0; bj < 2; ++bj)
#pragma unroll
                    for (int n = 0; n < 2; ++n) *(f32x4*)(rowp + bj * HALF + n * 16) = acc[ai][bj][m][n] * rs; }
    }
};
}

__device__ __forceinline__ void conv_trans_tile(const float* __restrict__ src, int ldsrc, int k0, int n0, h16* __restrict__ dst, int lddst, const float* __restrict__ rs, int rs_off, LAS unsigned char* lds) {
  LAS h16* tile = (LAS h16*)lds;
  const int tid = threadIdx.x;
  const int c4 = tid & 31, r = tid >> 5;
  f32x4 v[4];
#pragma unroll
  for (int p = 0; p < 4; ++p) v[p] = *(const f32x4*)(src + (size_t)(k0 + r + 16 * p) * ldsrc + n0 + c4 * 4);
  __syncthreads();
#pragma unroll
  for (int p = 0; p < 4; ++p) { const int k = r + 16 * p; float s = 1.0f; if (rs) { int kk = k0 + k + rs_off; s = kk >= 0 ? rs[kk] : 1.0f; }
#pragma unroll
    for (int j = 0; j < 4; ++j) tile[(c4 * 4 + j) * 72 + k] = (h16)(v[p][j] * s); }
  __syncthreads();
#pragma unroll
  for (int p = 0; p < 2; ++p) { const int n = (tid >> 3) + 64 * p, k8 = (tid & 7) * 8;
    const u32x4 w = *(const LAS u32x4*)(tile + n * 72 + k8);
    *(u32x4*)(dst + (size_t)(n0 + n) * lddst + k0 + k8) = w; }
}
__device__ __forceinline__ void conv_copy_rows(const float* __restrict__ src, int ldsrc, int r0, int rows, int cols, h16* __restrict__ dst, int lddst, const float* __restrict__ rs) {
  const int per_row = cols >> 3, total = rows * per_row;
  for (int i = threadIdx.x; i < total; i += NTHREADS) { const int r = r0 + i / per_row, c = (i % per_row) * 8;
    const float s = rs ? rs[r] : 1.0f;
    const f32x4 a = *(const f32x4*)(src + (size_t)r * ldsrc + c), b = *(const f32x4*)(src + (size_t)r * ldsrc + c + 4);
    u32x4 w; w.x = pk_h2(a[0] * s, a[1] * s); w.y = pk_h2(a[2] * s, a[3] * s); w.z = pk_h2(b[0] * s, b[1] * s); w.w = pk_h2(b[2] * s, b[3] * s);
    *(u32x4*)(dst + (size_t)r * lddst + c) = w; }
}
__device__ __forceinline__ void conv_rows_norm(const float* __restrict__ x, int row0, h16* __restrict__ x16, float* __restrict__ rstd_out, const float* __restrict__ g) {
  const int lane = threadIdx.x & 63, row = row0 + (threadIdx.x >> 6);
  const float* xr = x + (size_t)row * 2048; f32x4 a[4], b[4]; float ss = 0.f;
#pragma unroll
  for (int j = 0; j < 4; ++j) { a[j] = *(const f32x4*)(xr + (j * 64 + lane) * 8); b[j] = *(const f32x4*)(xr + (j * 64 + lane) * 8 + 4);
    ss += (a[j][0] * a[j][0] + a[j][1] * a[j][1]) + (a[j][2] * a[j][2] + a[j][3] * a[j][3]) + (b[j][0] * b[j][0] + b[j][1] * b[j][1]) + (b[j][2] * b[j][2] + b[j][3] * b[j][3]); }
  ss = wave_sum(ss);
  const float r = rsqrtf(ss * (1.0f / 2048.0f) + EPS_);
  if (rstd_out && lane == 0) rstd_out[row] = r;
#pragma unroll
  for (int j = 0; j < 4; ++j) { f32x4 p = a[j], q = b[j];
    if (g) { const f32x4 g0 = *(const f32x4*)(g + (j * 64 + lane) * 8), g1 = *(const f32x4*)(g + (j * 64 + lane) * 8 + 4); p = p * g0 * r; q = q * g1 * r; }
    u32x4 w; w.x = pk_h2(p[0], p[1]); w.y = pk_h2(p[2], p[3]); w.z = pk_h2(q[0], q[1]); w.w = pk_h2(q[2], q[3]);
    *(u32x4*)(x16 + (size_t)row * 2048 + (j * 64 + lane) * 8) = w; }
}
__device__ __forceinline__ void conv_table_rows(const float* __restrict__ tab, int row0, unsigned char* __restrict__ t8, float* __restrict__ sc) {
  const int lane = threadIdx.x & 63, row = row0 + (threadIdx.x >> 6);
  const float* xr = tab + (size_t)row * 2048; f32x4 a[4], b[4]; float mx = 0.f;
#pragma unroll
  for (int j = 0; j < 4; ++j) { a[j] = *(const f32x4*)(xr + (j * 64 + lane) * 8); b[j] = *(const f32x4*)(xr + (j * 64 + lane) * 8 + 4);
    mx = fmaxf(mx, fmaxf(fmaxf(fabsf(a[j][0]), fabsf(a[j][1])), fmaxf(fabsf(a[j][2]), fabsf(a[j][3]))));
    mx = fmaxf(mx, fmaxf(fmaxf(fabsf(b[j][0]), fabsf(b[j][1])), fmaxf(fabsf(b[j][2]), fabsf(b[j][3])))); }
  mx = wave_max(mx);
  const float s = mx > 0.f ? 400.0f / mx : 1.0f;
  if (lane == 0) sc[row] = mx > 0.f ? mx * (1.0f / 400.0f) : 1.0f;
#pragma unroll
  for (int j = 0; j < 4; ++j) { int w0 = __builtin_amdgcn_cvt_pk_fp8_f32(a[j][0] * s, a[j][1] * s, 0, false); w0 = __builtin_amdgcn_cvt_pk_fp8_f32(a[j][2] * s, a[j][3] * s, w0, true);
    int w1 = __builtin_amdgcn_cvt_pk_fp8_f32(b[j][0] * s, b[j][1] * s, 0, false); w1 = __builtin_amdgcn_cvt_pk_fp8_f32(b[j][2] * s, b[j][3] * s, w1, true);
    u32x2 w; w.x = (unsigned)w0; w.y = (unsigned)w1;
    *(u32x2*)(t8 + (size_t)row * 2048 + (j * 64 + lane) * 8) = w; }
}
__device__ __forceinline__ void sgu_pool_item(int nb, int q, const h16* __restrict__ U, const h16* __restrict__ V, const h16* __restrict__ Z, const f32x2* __restrict__ lnst,
                                              const float* __restrict__ ln_g, const float* __restrict__ ln_b, const h16* __restrict__ Wsgu, const float* __restrict__ sgu_b,
                                              h16* __restrict__ A2, LAS unsigned char* lds) {
  const int tid = threadIdx.x, lane = tid & 63, wid = tid >> 6;
  LAS h16* vt = (LAS h16*)lds;
  LAS f32x2* stat = (LAS f32x2*)(lds + 36864);
  const int t0 = nb * 128;
  __syncthreads();
  if (tid < 128) { const f32x2* p = lnst + (size_t)(t0 + tid) * 16; float s = 0.f, ss = 0.f;
#pragma unroll
    for (int i = 0; i < 16; ++i) { const f32x2 v = p[i]; s += v.x; ss += v.y; }
    const float mean = s * (1.0f / 1024.0f); const float var = fmaxf(ss * (1.0f / 1024.0f) - mean * mean, 0.f);
    stat[tid] = (f32x2){mean, rsqrtf(var + EPS_)}; }
  __syncthreads();
  for (int hh = 0; hh < 4; ++hh) {
    const int h = 4 * q + hh;
#pragma unroll
    for (int i = 0; i < 4; ++i) { const int ch = tid + NTHREADS * i; const int j = ch >> 4, d8 = (ch & 15) * 8;
      const half8 v = *(const half8*)(V + (size_t)(t0 + j) * 1024 + h * 128 + d8);
      const f32x2 st = stat[j];
      const f32x4 g0 = *(const f32x4*)(ln_g + h * 128 + d8), g1 = *(const f32x4*)(ln_g + h * 128 + d8 + 4), b0 = *(const f32x4*)(ln_b + h * 128 + d8), b1 = *(const f32x4*)(ln_b + h * 128 + d8 + 4);
#pragma unroll
      for (int e = 0; e < 8; ++e) { const float gg = e < 4 ? g0[e & 3] : g1[e & 3], bb = e < 4 ? b0[e & 3] : b1[e & 3];
        vt[(d8 + e) * 136 + j] = (h16)(((float)v[e] - st.x) * st.y * gg + bb); } }
    __syncthreads();
    f32x4 acc[8];
#pragma unroll
    for (int nt = 0; nt < 8; ++nt) acc[nt] = (f32x4){0.f, 0.f, 0.f, 0.f};
    const int i_row = 16 * wid + (lane & 15);
    const int ksteps = (wid < 4) ? 2 : 4;
    for (int kk = 0; kk < ksteps; ++kk) {
      const half8 wf = *(const half8*)(Wsgu + ((size_t)h * 128 + i_row) * 128 + kk * 32 + 8 * (lane >> 4));
#pragma unroll
      for (int nt = 0; nt < 8; ++nt) { const half8 vf = *(const LAS half8*)(vt + (16 * nt + (lane & 15)) * 136 + kk * 32 + 8 * (lane >> 4));
        acc[nt] = __builtin_amdgcn_mfma_f32_16x16x32_f16(vf, wf, acc[nt], 0, 0, 0); }
    }
    const float bias = sgu_b[h * 128 + i_row];
    const size_t tok = (size_t)(t0 + i_row);
#pragma unroll
    for (int nt = 0; nt < 8; ++nt) { const int d0 = 16 * nt + 4 * (lane >> 4);
      const half4 uu = *(const half4*)(U + tok * 1024 + h * 128 + d0);
      u32x2 w; w.x = pk_h2((float)uu[0] * (acc[nt][0] + bias), (float)uu[1] * (acc[nt][1] + bias)); w.y = pk_h2((float)uu[2] * (acc[nt][2] + bias), (float)uu[3] * (acc[nt][3] + bias));
      *(u32x2*)(A2 + tok * 2048 + h * 128 + d0) = w; }
    __syncthreads();
  }
  { const int cc = tid & 63, tr = tid >> 6; const int col = 512 * q + cc * 8; const int g = col >> 8, w = 2 << g;
    const int tfirst = t0 + tr * 16; const int pos0 = tfirst & (SEQ_ - 1);
    float sum[8];
#pragma unroll
    for (int e = 0; e < 8; ++e) sum[e] = 0.f;
    for (int s = 1; s < w; ++s) { if (pos0 - s >= 0) { const half8 z = *(const half8*)(Z + (size_t)(tfirst - s) * 1024 + col);
#pragma unroll
        for (int e = 0; e < 8; ++e) sum[e] += (float)z[e]; } }
    for (int i = 0; i < 16; ++i) { const int t = tfirst + i, pos = pos0 + i;
      const half8 z = *(const half8*)(Z + (size_t)t * 1024 + col);
#pragma unroll
      for (int e = 0; e < 8; ++e) sum[e] += (float)z[e];
      const int cnt = pos + 1 < w ? pos + 1 : w; const float inv = 1.0f / (float)cnt;
      u32x4 o; float y[8];
#pragma unroll
      for (int e = 0; e < 8; ++e) y[e] = sum[e] * inv - (float)z[e];
      o.x = pk_h2(y[0], y[1]); o.y = pk_h2(y[2], y[3]); o.z = pk_h2(y[4], y[5]); o.w = pk_h2(y[6], y[7]);
      *(u32x4*)(A2 + (size_t)t * 2048 + 1024 + col) = o;
      if (pos - w + 1 >= 0) { const half8 zo = *(const half8*)(Z + (size_t)(t - w + 1) * 1024 + col);
#pragma unroll
        for (int e = 0; e < 8; ++e) sum[e] -= (float)zo[e]; } }
  }
}
constexpr int P6_TS = 0, P6_TI = 32768, P6_IG = 40960, P6_GU = 73728, P6_GV = 106496;
__device__ __forceinline__ void peer_topk(const float* S, const float* SU, const float* SV, int tw0, LAS unsigned char* lds) {
  LAS float* ts = (LAS float*)(lds + P6_TS); LAS unsigned char* ti = lds + P6_TI; LAS int* ig = (LAS int*)(lds + P6_IG); LAS float* gu = (LAS float*)(lds + P6_GU); LAS float* gv = (LAS float*)(lds + P6_GV);
  const int tid = threadIdx.x;
  for (int r = 0; r < 2; ++r) {
    { const int tl = tid >> 4, l = tid & 15; const int t = tw0 + 32 * r + tl;
      const float* sp = S + (size_t)t * 2048 + l * 128;
      float v[16]; int ix[16];
#pragma unroll
      for (int k = 0; k < 16; ++k) { v[k] = -INFINITY; ix[k] = 0; }
      for (int j4 = 0; j4 < 32; ++j4) { const f32x4 x4 = *(const f32x4*)(sp + j4 * 4);
#pragma unroll
        for (int e = 0; e < 4; ++e) { float x = x4[e]; int xi = j4 * 4 + e;
#pragma unroll
          for (int k = 0; k < 16; ++k) { const bool gt = x > v[k]; const float tv = gt ? v[k] : x; const int tix = gt ? ix[k] : xi; v[k] = gt ? x : v[k]; ix[k] = gt ? xi : ix[k]; x = tv; xi = tix; } } }
      __syncthreads();
#pragma unroll
      for (int k = 0; k < 16; ++k) { ts[(tl * 16 + l) * 16 + k] = v[k]; ti[(tl * 16 + l) * 16 + k] = (unsigned char)ix[k]; }
    }
    __syncthreads();
    if (tid < 256) { const int tl = tid >> 3, h = tid & 7;
      LAS const float* pa = ts + (tl * 16 + 2 * h) * 16; LAS const float* pb = pa + 16;
      float a[16], b[16];
#pragma unroll
      for (int k = 0; k < 16; ++k) { a[k] = pa[k]; b[k] = pb[k]; }
      float bs[16]; int bc[16];
#pragma unroll
      for (int k = 0; k < 16; ++k) { bs[k] = -INFINITY; bc[k] = 0; }
#pragma unroll
      for (int i = 0; i < 16; ++i)
#pragma unroll
        for (int j = 0; j < 16; ++j) if ((i + 1) * (j + 1) <= 16) { float x = a[i] + b[j]; int xi = i * 16 + j;
#pragma unroll
          for (int k = 0; k < 16; ++k) { const bool gt = x > bs[k]; const float tv = gt ? bs[k] : x; const int tix = gt ? bc[k] : xi; bs[k] = gt ? x : bs[k]; bc[k] = gt ? xi : bc[k]; x = tv; xi = tix; } }
      float ex[16]; float sum = 0.f;
#pragma unroll
      for (int k = 0; k < 16; ++k) { ex[k] = __expf(bs[k] - bs[0]); sum += ex[k]; }
      const float inv = 1.0f / sum;
      LAS const unsigned char* ia = ti + (tl * 16 + 2 * h) * 16; LAS const unsigned char* ib = ia + 16;
#pragma unroll
      for (int k = 0; k < 16; ++k) { const int id = (int)ia[bc[k] >> 4] * 128 + (int)ib[bc[k] & 15]; const int o = (32 * r + tl) * 128 + h * 16 + k;
        ig[o] = id; gu[o] = SU[id]; gv[o] = ex[k] * inv * SV[id]; }
    }
  }
  __syncthreads();
  { const int lane = tid & 63, wv = tid >> 6;
    for (int it = 0; it < 8; ++it) { LAS int* row = ig + (8 * wv + it) * 128;
      unsigned k0 = ((unsigned)row[lane] << 7) | (unsigned)lane, k1 = ((unsigned)row[lane + 64] << 7) | (unsigned)(lane + 64);
#pragma unroll
      for (int k = 2; k <= 128; k <<= 1) {
#pragma unroll
        for (int j = k >> 1; j > 0; j >>= 1) {
          if (j == 64) { const unsigned lo = k0 < k1 ? k0 : k1, hi = k0 < k1 ? k1 : k0; k0 = lo; k1 = hi; }
          else { const unsigned p0 = (unsigned)__shfl_xor((int)k0, j), p1 = (unsigned)__shfl_xor((int)k1, j);
            const bool lower = (lane & j) == 0;
            const bool asc0 = (k == 128) ? true : (k == 64 ? true : ((lane & k) == 0));
            const bool asc1 = (k == 128) ? true : (k == 64 ? false : ((lane & k) == 0));
            const unsigned mn0 = k0 < p0 ? k0 : p0, mx0 = k0 < p0 ? p0 : k0, mn1 = k1 < p1 ? k1 : p1, mx1 = k1 < p1 ? p1 : k1;
            k0 = (lower == asc0) ? mn0 : mx0; k1 = (lower == asc1) ? mn1 : mx1; } } }
      row[lane] = (int)k0; row[lane + 64] = (int)k1; } }
  __syncthreads();
}

struct RowBuf { u32x4 u0, u1, v0, v1; };
__device__ __forceinline__ void fp8x4_to_f32(unsigned w, float* o) { const f32x2 lo = __builtin_amdgcn_cvt_pk_f32_fp8((int)w, false), hi = __builtin_amdgcn_cvt_pk_f32_fp8((int)w, true); o[0] = lo.x; o[1] = lo.y; o[2] = hi.x; o[3] = hi.y; }

__device__ __forceinline__ void peer_gather_wave(const h16* h2, float* out, const unsigned char* U8, const unsigned char* V8, const float* __restrict__ g_peer, const float* __restrict__ g_final,
                                                 int t0, int tl0, int ntok, LAS unsigned char* lds) {
  LAS const int* ig = (LAS const int*)(lds + P6_IG); LAS const float* gu = (LAS const float*)(lds + P6_GU); LAS const float* gv = (LAS const float*)(lds + P6_GV);
  const int lane = threadIdx.x & 63;
  for (int it = 0; it < ntok; ++it) {
    const int t = t0 + it, tl = tl0 + it;
    asm volatile("" ::: "memory");
    const h16* hr = h2 + (size_t)t * 2048; float* orow = out + (size_t)t * 2048;
    float n[32], acc[32]; float ss = 0.f;
#pragma unroll
    for (int j = 0; j < 2; ++j)
#pragma unroll
      for (int q = 0; q < 2; ++q) { const half8 x = *(const half8*)(hr + (j * 64 + lane) * 16 + q * 8);
#pragma unroll
        for (int e = 0; e < 8; ++e) { const float xf = (float)x[e]; n[j * 16 + q * 8 + e] = xf; ss += xf * xf; } }
    ss = wave_sum(ss);
    const float r3 = rsqrtf(ss * (1.0f / 2048.0f) + EPS_);
#pragma unroll
    for (int j = 0; j < 2; ++j)
#pragma unroll
      for (int q = 0; q < 4; ++q) { const f32x4 g = *(const f32x4*)(g_peer + (j * 64 + lane) * 16 + q * 4);
#pragma unroll
        for (int e = 0; e < 4; ++e) { n[j * 16 + q * 4 + e] *= r3 * g[e]; acc[j * 16 + q * 4 + e] = 0.f; } }
    LAS const int* igt = ig + tl * 128; LAS const float* gut = gu + tl * 128; LAS const float* gvt = gv + tl * 128;
#define P6_LOAD(B, E) do { const int _id = __builtin_amdgcn_readfirstlane(igt[(E) < 128 ? (E) : 127]) >> 7; const unsigned char* _up = U8 + (size_t)_id * 2048 + lane * 16; const unsigned char* _vp = V8 + (size_t)_id * 2048 + lane * 16; \
      B.u0 = *(const u32x4*)_up; B.u1 = *(const u32x4*)(_up + 1024); B.v0 = *(const u32x4*)_vp; B.v1 = *(const u32x4*)(_vp + 1024); } while (0)
#define P6_PROC(B, E) do { float dot = 0.f; float f[4]; \
      _Pragma("unroll") for (int q = 0; q < 4; ++q) { fp8x4_to_f32(B.u0[q], f); dot += (f[0] * n[q * 4 + 0] + f[1] * n[q * 4 + 1]) + (f[2] * n[q * 4 + 2] + f[3] * n[q * 4 + 3]); } \
      _Pragma("unroll") for (int q = 0; q < 4; ++q) { fp8x4_to_f32(B.u1[q], f); dot += (f[0] * n[16 + q * 4 + 0] + f[1] * n[16 + q * 4 + 1]) + (f[2] * n[16 + q * 4 + 2] + f[3] * n[16 + q * 4 + 3]); } \
      const int _sl = __builtin_amdgcn_readfirstlane(igt[E]) & 127; dot = wave_sum(dot) * gut[_sl]; const float a = gelu_f(dot) * gvt[_sl]; \
      _Pragma("unroll") for (int q = 0; q < 4; ++q) { fp8x4_to_f32(B.v0[q], f); acc[q * 4 + 0] += a * f[0]; acc[q * 4 + 1] += a * f[1]; acc[q * 4 + 2] += a * f[2]; acc[q * 4 + 3] += a * f[3]; } \
      _Pragma("unroll") for (int q = 0; q < 4; ++q) { fp8x4_to_f32(B.v1[q], f); acc[16 + q * 4 + 0] += a * f[0]; acc[16 + q * 4 + 1] += a * f[1]; acc[16 + q * 4 + 2] += a * f[2]; acc[16 + q * 4 + 3] += a * f[3]; } } while (0)
    RowBuf b0, b1, b2, b3;
    P6_LOAD(b0, 0); P6_LOAD(b1, 1); P6_LOAD(b2, 2); P6_LOAD(b3, 3);
    for (int e = 0; e < 128; e += 4) {
      P6_PROC(b0, e);     P6_LOAD(b0, e + 4);
      P6_PROC(b1, e + 1); P6_LOAD(b1, e + 5);
      P6_PROC(b2, e + 2); P6_LOAD(b2, e + 6);
      P6_PROC(b3, e + 3); P6_LOAD(b3, e + 7);
    }
#undef P6_LOAD
#undef P6_PROC
    asm volatile("" ::: "memory");
    float s2 = 0.f;
#pragma unroll
    for (int j = 0; j < 2; ++j)
#pragma unroll
      for (int q = 0; q < 2; ++q) { const half8 x = *(const half8*)(hr + (j * 64 + lane) * 16 + q * 8);
#pragma unroll
        for (int e = 0; e < 8; ++e) { const float hh = (float)x[e] + acc[j * 16 + q * 8 + e]; acc[j * 16 + q * 8 + e] = hh; s2 += hh * hh; } }
    s2 = wave_sum(s2);
    const float rf = rsqrtf(s2 * (1.0f / 2048.0f) + EPS_);
#pragma unroll
    for (int j = 0; j < 2; ++j)
#pragma unroll
      for (int q = 0; q < 4; ++q) { const f32x4 g = *(const f32x4*)(g_final + (j * 64 + lane) * 16 + q * 4); f32x4 o;
#pragma unroll
        for (int e = 0; e < 4; ++e) o[e] = acc[j * 16 + q * 4 + e] * rf * g[e];
        *(f32x4*)(orow + (j * 64 + lane) * 16 + q * 4) = o; }
  }
}
struct Args { const float* in[22]; float* out; unsigned char* ws; int ph_lo, ph_hi; };

__device__ __forceinline__ void p0a_chunk(int id, const Args& a, LAS unsigned char* lds) {
  unsigned char* ws = a.ws;
  const float* mem = a.in[1]; const float* g_mix = a.in[2]; const float* w_in = a.in[3]; const float* pool_w = a.in[8]; const float* g_mem = a.in[12]; const float* w_kv = a.in[14];
  const float* g_peer = a.in[16]; const float* w_query = a.in[17]; const float* sub_keys = a.in[18];
  if (id < 1024) { conv_trans_tile(w_kv, 4096, (id >> 5) * 64, (id & 31) * 128, (h16*)(ws + O_WKVT), 2048, nullptr, 0, lds); return; }
  id -= 1024;
  if (id < 64) { conv_rows_norm(mem, id * 8, (h16*)(ws + O_M16), nullptr, g_mem); return; }
  id -= 64;
  if (id < 128) { conv_copy_rows(w_in + 2048, 3072, id * 16, 16, 1024, (h16*)(ws + O_WINZ), 1024, g_mix); return; }
  id -= 128;
  if (id < 32) { const int g = id >> 3, t = id & 7; conv_trans_tile(pool_w + (size_t)g * 65536, 256, (t >> 1) * 64, (t & 1) * 128, (h16*)(ws + O_WPOOLT) + (size_t)g * 65536, 256, nullptr, 0, lds); return; }
  id -= 32;
  if (id < 256) { conv_copy_rows(w_query, 2048, id * 8, 8, 2048, (h16*)(ws + O_WQRY), 2048, g_peer); return; }
  id -= 256;
  { h16* dst = (h16*)(ws + O_SKBD);
    for (int i = threadIdx.x; i < 2048; i += NTHREADS) { const int e0 = id * 16384 + i * 8; const int h = e0 >> 16, r = (e0 >> 8) & 255, c = e0 & 255; const int p = r >> 7, key = r & 127, pp = c >> 7, cc = c & 127;
      u32x4 w = (u32x4){0u, 0u, 0u, 0u};
      if (p == pp) { const float* s = sub_keys + ((size_t)((h * 2 + p) * 128 + key)) * 128 + cc; const f32x4 x = *(const f32x4*)s, y = *(const f32x4*)(s + 4);
        w.x = pk_h2(x[0], x[1]); w.y = pk_h2(x[2], x[3]); w.z = pk_h2(y[0], y[1]); w.w = pk_h2(y[2], y[3]); }
      *(u32x4*)(dst + e0) = w; } }
}
constexpr int P0A_CHUNKS = 1024 + 64 + 128 + 32 + 256 + 32;

__device__ __forceinline__ void p0b_chunk(int id, const Args& a, LAS unsigned char* lds) {
  unsigned char* ws = a.ws;
  const float* x = a.in[0]; const float* g_mix = a.in[2]; const float* w_in = a.in[3]; const float* sgu_w = a.in[6]; const float* pool_scale = a.in[9]; const float* w_out = a.in[10];
  const float* g_xattn = a.in[11]; const float* w_q = a.in[13]; const float* w_o = a.in[15]; const float* peer_u = a.in[19]; const float* peer_v = a.in[20];
  if (id < 2048) { conv_rows_norm(x, id * 8, (h16*)(ws + O_X16), (float*)(ws + O_RSTD1), nullptr); return; }
  id -= 2048;
  if (id < 512) { conv_trans_tile(w_in, 3072, (id >> 4) * 64, (id & 15) * 128, (h16*)(ws + O_W1T), 2048, g_mix, 0, lds); return; }
  id -= 512;
  if (id < 512) { conv_trans_tile(w_out, 2048, (id >> 4) * 64, (id & 15) * 128, (h16*)(ws + O_W3T), 2048, pool_scale, -1024, lds); return; }
  id -= 512;
  if (id < 512) { conv_trans_tile(w_o, 2048, (id >> 4) * 64, (id & 15) * 128, (h16*)(ws + O_WOT), 2048, nullptr, 0, lds); return; }
  id -= 512;
  if (id < 256) { conv_copy_rows(w_q, 2048, id * 8, 8, 2048, (h16*)(ws + O_WQ16), 2048, g_xattn); return; }
  id -= 256;
  if (id < 8) { h16* dst = (h16*)(ws + O_WSGU);
    for (int i = threadIdx.x; i < 2048; i += NTHREADS) { const int e0 = id * 16384 + i * 8; const int ii = (e0 >> 7) & 127, j = e0 & 127;
      u32x4 w = (u32x4){0u, 0u, 0u, 0u};
      if ((j >> 6) <= (ii >> 6)) { const f32x4 p = *(const f32x4*)(sgu_w + e0), q = *(const f32x4*)(sgu_w + e0 + 4); w.x = pk_h2(p[0], p[1]); w.y = pk_h2(p[2], p[3]); w.z = pk_h2(q[0], q[1]); w.w = pk_h2(q[2], q[3]); }
      *(u32x4*)(dst + e0) = w; }
    return; }
  id -= 8;
  if (id < 2048) { conv_table_rows(peer_u, id * 8, ws + O_U8, (float*)(ws + O_SU)); return; }
  id -= 2048;
  conv_table_rows(peer_v, id * 8, ws + O_V8, (float*)(ws + O_SV));
}
constexpr int P0B_CHUNKS = 2048 + 512 * 3 + 256 + 8 + 4096;

#define XB_TMO      128
#define XB_XCNT(j)  (256  + 64 * (j))
#define XB_XSUB(j)  (1280 + 64 * (j))
#define XB_XGEN(j)  (2304 + 64 * (j))
#define XB_TOP      3328
#define XB_TOPGEN   3392
#define XCD_BAR_WORDS 3456
#define XB_SPIN_CAP (1u << 20)
__device__ __forceinline__ unsigned xb_ld(unsigned* p)              { return __hip_atomic_load(p, __ATOMIC_RELAXED, __HIP_MEMORY_SCOPE_AGENT); }
__device__ __forceinline__ unsigned xb_add(unsigned* p, unsigned v) { return __hip_atomic_fetch_add(p, v, __ATOMIC_RELAXED, __HIP_MEMORY_SCOPE_AGENT); }
__device__ __forceinline__ unsigned xb_xcc_id() { return (unsigned)__builtin_amdgcn_s_getreg((3 << 11) | 20) & 0xFu; }
#define XB_SPIN(cond, bar) do { unsigned _sp = 0; while (cond) { __builtin_amdgcn_s_sleep(1); \
    if ((++_sp & 255u) == 0u) { if (xb_ld(&(bar)[XB_TMO])) break; if (_sp > XB_SPIN_CAP) { atomicAdd(&(bar)[XB_TMO], 1u); break; } } } } while (0)
struct XcdBarrier { unsigned* bar; unsigned x; volatile LAS unsigned* st; };
__device__ __forceinline__ XcdBarrier xcd_barrier_post(unsigned* bar, volatile LAS unsigned* st) {
  XcdBarrier b; b.bar = bar; b.x = xb_xcc_id(); b.st = st;
  if (threadIdx.x == 0) (void)xb_add(&bar[XB_XCNT(b.x)], 1u);
  return b;
}
__device__ __forceinline__ void xcd_barrier_complete(unsigned* bar, unsigned x, unsigned& nloc, unsigned& nx) {
  const unsigned G = gridDim.x; unsigned sum, cnt, mine, sp = 0u;
  for (;;) { sum = 0u; cnt = 0u; mine = 0u;
#pragma unroll
    for (unsigned j = 0; j < 16; ++j) { const unsigned c = xb_ld(&bar[XB_XCNT(j)]); sum += c; cnt += (c > 0u) ? 1u : 0u; mine = (j == x) ? c : mine; }
    if (sum == G) break;
    __builtin_amdgcn_s_sleep(1);
    if ((++sp & 255u) == 0u) { if (xb_ld(&bar[XB_TMO])) break; if (sp > XB_SPIN_CAP) { atomicAdd(&bar[XB_TMO], 1u); break; } } }
  nloc = mine > 0u ? mine : 1u; nx = cnt > 0u ? cnt : 1u;
}
__device__ __forceinline__ void xcd_barrier(const XcdBarrier& b) {
  asm volatile("s_waitcnt vmcnt(0)" ::: "memory");
  __syncthreads();
  if (threadIdx.x == 0) {
    unsigned* bar = b.bar;
    __builtin_amdgcn_s_waitcnt(0);
    unsigned nloc = b.st[0], nx = b.st[1];
    if (nloc == 0u) { xcd_barrier_complete(bar, b.x, nloc, nx); b.st[0] = nloc; b.st[1] = nx; }
    const unsigned old = xb_add(&bar[XB_XSUB(b.x)], 1u);
    const unsigned gen = old / nloc;
    if (old + 1u == (gen + 1u) * nloc) {
      __builtin_amdgcn_fence(__ATOMIC_RELEASE, "agent");
      asm volatile("s_waitcnt vmcnt(0)" ::: "memory");
      const unsigned og = xb_add(&bar[XB_TOP], 1u);
      const unsigned tg = og / nx;
      if (og + 1u == (tg + 1u) * nx) xb_add(&bar[XB_TOPGEN], 1u);
      else XB_SPIN(xb_ld(&bar[XB_TOPGEN]) == tg, bar);
      __builtin_amdgcn_fence(__ATOMIC_ACQUIRE, "agent");
      xb_add(&bar[XB_XGEN(b.x)], 1u);
      asm volatile("s_waitcnt vmcnt(0)" ::: "memory");
    } else {
      XB_SPIN(xb_ld(&bar[XB_XGEN(b.x)]) == gen, bar);
      __builtin_amdgcn_fence(__ATOMIC_ACQUIRE, "agent");
      asm volatile("s_waitcnt vmcnt(0)" ::: "memory");
    }
  }
  __syncthreads();
}

constexpr int NPHASE = 9;
constexpr int CW_QUEUE = 0;
constexpr int CW_BAR = 1024;

__global__ void __launch_bounds__(NTHREADS, 2) fwd_kernel(Args a) {
  extern __shared__ __attribute__((aligned(16))) unsigned char lds_raw[];
  LAS unsigned char* lds = (LAS unsigned char*)lds_raw;
  const int tid = threadIdx.x, c = blockIdx.x, G = gridDim.x;
  unsigned char* ws = a.ws; unsigned* ctl = (unsigned*)(ws + O_CTL);
  volatile LAS unsigned* misc = (volatile LAS unsigned*)(lds + LDS_BYTES - 64);
  if (tid < 16) misc[tid] = 0u;
  __syncthreads();
  const bool multi = (a.ph_hi - a.ph_lo) > 1;
  XcdBarrier bar; bar.bar = ctl + CW_BAR; bar.x = 0; bar.st = misc + 8;
  if (multi) bar = xcd_barrier_post(ctl + CW_BAR, misc + 8);
#define IN(k) (a.ph_lo <= (k) && (k) < a.ph_hi)
#define SEAM(k) do { if (IN(k) && IN((k) + 1)) xcd_barrier(bar); } while (0)
  const long NOB = 1L << 30;
  if (IN(0)) { for (int id = c; id < P0A_CHUNKS; id += G) p0a_chunk(id, a, lds); }
  SEAM(0);
  if (IN(1)) {
    if (c < 32) { pg::Gemm g{(const h16*)(ws + O_M16), (const h16*)(ws + O_WKVT), 2048, 2048, 2048, (int)NOB, 0}; pg::OneUnit S{{c >> 4, c & 15}}; pg::EpiHalf E{(h16*)(ws + O_KV16), 4096};
      pg::gemm_phase(lds, g, S, E); }
    else if (c < 64) { const int z = (c - 32) >> 3, pn = (c - 32) & 7;
      pg::Gemm g{(const h16*)(ws + O_WPOOLT) + (size_t)z * 65536, (const h16*)(ws + O_WINZ) + z * 256, 256, 1024, 256, (int)NOB, 0}; pg::OneUnit S{{0, pn}};
      pg::EpiHalf E{(h16*)(ws + O_W1T) + (size_t)(2048 + z * 256) * 2048, 2048}; pg::gemm_phase(lds, g, S, E); }
    else if (c < 128) { const int z = (c - 64) >> 3, pn = (c - 64) & 7;
      pg::Gemm g{(const h16*)(ws + O_SKBD) + (size_t)z * 65536, (const h16*)(ws + O_WQRY) + z * 256, 256, 2048, 256, (int)NOB, 0}; pg::OneUnit S{{0, pn}};
      pg::EpiHalf E{(h16*)(ws + O_WQST) + (size_t)z * 256 * 2048, 2048}; pg::gemm_phase(lds, g, S, E); }
    for (;;) { __syncthreads(); if (tid == 0) misc[0] = atomicAdd(ctl + CW_QUEUE, 1u); __syncthreads(); const int id = (int)misc[0]; if (id >= P0B_CHUNKS) break; p0b_chunk(id, a, lds); }
  }
  SEAM(1);
  if (IN(2)) { pg::Gemm g{(const h16*)(ws + O_X16), (const h16*)(ws + O_W1T), 2048, 2048, 2048, (int)NOB, 0}; pg::StaticOrder S; S.init(64, 12, G, c);
    pg::Epi1 E{(const float*)(ws + O_RSTD1), (h16*)(ws + O_RB), (f32x2*)(ws + O_LNST)};
    pg::gemm_phase(lds, g, S, E); }
  SEAM(2);
  if (IN(3)) {
    if (c < 64) { const int z = c >> 3, pn = c & 7, b = z >> 2, h = z & 3;
      pg::Gemm g{(const h16*)(ws + O_KV16) + (size_t)(b * 256) * 4096 + h * 512, (const h16*)(ws + O_WQ16) + h * 512, 4096, 2048, 512, (int)NOB, 0}; pg::OneUnit S{{0, pn}};
      pg::EpiHalf E{(h16*)(ws + O_WQKT) + (size_t)(b * 1024 + h * 256) * 2048, 2048}; pg::gemm_phase(lds, g, S, E); }
    else if (c < 128) { const int z = (c - 64) >> 3, pm = (c - 64) & 7, b = z >> 2, h = z & 3;
      pg::Gemm g{(const h16*)(ws + O_WOT) + h * 512, (const h16*)(ws + O_KV16) + (size_t)(b * 256) * 4096 + 2048 + h * 512, 2048, 4096, 512, (int)NOB, 0}; pg::OneUnit S{{pm, 0}};
      pg::EpiHalf E{(h16*)(ws + O_WVOT) + (size_t)b * 2048 * 1024 + h * 256, 1024}; pg::gemm_phase(lds, g, S, E); }
    for (int it = c; it < 256; it += G)
      sgu_pool_item(it >> 1, it & 1, (const h16*)(ws + O_RB), (const h16*)(ws + O_RB + 32 * MiB), (const h16*)(ws + O_RB + 64 * MiB), (const f32x2*)(ws + O_LNST), a.in[4], a.in[5],
                    (const h16*)(ws + O_WSGU), a.in[7], (h16*)(ws + O_RA), lds);
  }
  SEAM(3);
  if (IN(4)) { pg::Gemm g{(const h16*)(ws + O_RA), (const h16*)(ws + O_W3T), 2048, 2048, 2048, (int)NOB, 0}; pg::StaticOrder S; S.init(64, 8, G, c);
    pg::EpiRes E{(const h16*)(ws + O_X16), (h16*)(ws + O_RB), (float*)(ws + O_SSQ2)}; pg::gemm_phase(lds, g, S, E); }
  SEAM(4);
  if (IN(5)) { pg::Gemm g{(const h16*)(ws + O_RB), (const h16*)(ws + O_WQKT), 2048, 2048, 2048, 32, (long)1024 * 2048}; pg::StaticOrder S; S.init(64, 4, G, c);
    pg::EpiSoftmax E{(const float*)(ws + O_SSQ2), (h16*)(ws + O_RB + 64 * MiB)}; pg::gemm_phase<pg::EpiSoftmax, pg::StaticOrder, false, true>(lds, g, S, E); }
  SEAM(5);
  if (IN(6)) { pg::Gemm g{(const h16*)(ws + O_RB + 64 * MiB), (const h16*)(ws + O_WVOT), 1024, 1024, 1024, 32, (long)2048 * 1024}; pg::StaticOrder S; S.init(64, 8, G, c);
    pg::EpiRes E{(const h16*)(ws + O_RB), (h16*)(ws + O_RA), (float*)(ws + O_SSQ3)}; pg::gemm_phase(lds, g, S, E); }
  SEAM(6);
  if (IN(7)) { pg::Gemm g{(const h16*)(ws + O_RA), (const h16*)(ws + O_WQST), 2048, 2048, 2048, (int)NOB, 0}; pg::StaticOrder S; S.init(64, 8, G, c);
    pg::EpiScore E{(const float*)(ws + O_SSQ3), (float*)(ws + O_RB)}; pg::gemm_phase(lds, g, S, E); }
  SEAM(7);
  if (IN(8)) {
    peer_topk((const float*)(ws + O_RB), (const float*)(ws + O_SU), (const float*)(ws + O_SV), 64 * c, lds);
    const int wid = tid >> 6;
    peer_gather_wave((const h16*)(ws + O_RA), a.out, ws + O_U8, ws + O_V8, a.in[16], a.in[21], 64 * c + 8 * wid, 8 * wid, 8, lds);
  }
#undef IN
#undef SEAM
}
#ifndef HYBRID_CUT
#define HYBRID_CUT 9
#endif
#ifndef ONE_LAUNCH
#define ONE_LAUNCH 0
#endif

#if HYBRID_CUT < 9
static void slow_xattn(hipStream_t stream, void* const* d_in, float* h, float* ws) {
  const float* mem = (const float*)d_in[1]; const float* g_xattn = (const float*)d_in[11]; const float* g_mem = (const float*)d_in[12]; const float* w_q = (const float*)d_in[13]; const float* w_kv = (const float*)d_in[14]; const float* w_o = (const float*)d_in[15];
  float* R0 = ws; float* R1 = R0 + (size_t)TT * 3072; float* S0 = R1 + (size_t)TT * 2048; float* mnorm = S0; float* kv = S0 + (size_t)512 * 2048;
  hipLaunchKernelGGL(k_rmsnorm, dim3(TT), dim3(256), 0, stream, (const float*)h, g_xattn, R1);
  hipLaunchKernelGGL(k_rmsnorm, dim3(512), dim3(256), 0, stream, mem, g_mem, mnorm);
  gemm(stream, mnorm, 2048, w_kv, 4096, 0, kv, 4096, nullptr, 512, 4096, 2048);
  float* q = R0; float* sc = R0 + (size_t)TT * 2048;
  gemm(stream, R1, 2048, w_q, 2048, 0, q, 2048, nullptr, TT, 2048, 2048);
  gemm(stream, q, 2048, kv, 4096, 1, sc, 256, nullptr, SEQ, 256, 512, 8, 4, (long)SEQ * 2048, 512, (long)256 * 4096, 512, (long)4 * SEQ * 256, (long)SEQ * 256);
  hipLaunchKernelGGL(k_softmax256, dim3(8 * SEQ / 4), dim3(256), 0, stream, sc, 0.044194173824159216f);
  gemm(stream, sc, 256, kv + 2048, 4096, 0, R1, 2048, nullptr, SEQ, 512, 256, 8, 4, (long)4 * SEQ * 256, (long)SEQ * 256, (long)256 * 4096, 512, (long)SEQ * 2048, 512);
  gemm(stream, R1, 2048, w_o, 2048, 0, h, 2048, h, TT, 2048, 2048);
}
static void slow_peer(hipStream_t stream, void* const* d_in, float* h, float* ws, float* out) {
  const float* g_peer = (const float*)d_in[16]; const float* w_query = (const float*)d_in[17]; const float* sub_keys = (const float*)d_in[18]; const float* peer_u = (const float*)d_in[19]; const float* peer_v = (const float*)d_in[20]; const float* g_final = (const float*)d_in[21];
  float* R0 = ws; float* R1 = R0 + (size_t)TT * 3072; float* S0 = R1 + (size_t)TT * 2048;
  int* idx = (int*)(S0 + (size_t)TT * 1024); float* gates = S0 + (size_t)TT * 1024 + (size_t)TT * 128;
  hipLaunchKernelGGL(k_rmsnorm, dim3(TT), dim3(256), 0, stream, (const float*)h, g_peer, R1);
  float* pq = R0; float* pscore = R1;
  gemm(stream, R1, 2048, w_query, 2048, 0, pq, 2048, nullptr, TT, 2048, 2048);
  gemm(stream, pq, 2048, sub_keys, 128, 1, pscore, 2048, nullptr, TT, 128, 128, 16, 1, 128, 0, 16384, 0, 128, 0);
  hipLaunchKernelGGL(k_topk, dim3(TT * 8 / 4), dim3(256), 0, stream, (const float*)pscore, idx, gates);
  hipLaunchKernelGGL(k_experts, dim3(TT / 4), dim3(256), 0, stream, g_peer, (const float*)h, (const int*)idx, (const float*)gates, peer_u, peer_v, g_final, out);
}
#endif

extern "C" void kernel_launch(void* const* d_in, const int* in_sizes, int n_in, void* d_out, int out_size, void* d_ws, size_t ws_size, hipStream_t stream) {
  static int grid = 0;
  if (grid == 0) {
    if (n_in != 22 || out_size != T_ * D_ || ws_size < WS_END) { fprintf(stderr, "kernel_launch: unexpected problem shape (n_in %d out %d ws %zu need %zu)\n", n_in, out_size, ws_size, (size_t)WS_END); grid = -1; return; }
    int dev = 0, cus = 0, per_cu = 0;
    (void)hipGetDevice(&dev); (void)hipDeviceGetAttribute(&cus, hipDeviceAttributeMultiprocessorCount, dev);
    if (hipFuncSetAttribute((const void*)fwd_kernel, hipFuncAttributeMaxDynamicSharedMemorySize, LDS_BYTES) != hipSuccess) { fprintf(stderr, "kernel_launch: hipFuncSetAttribute failed\n"); grid = -1; return; }
    (void)hipOccupancyMaxActiveBlocksPerMultiprocessor(&per_cu, (const void*)fwd_kernel, NTHREADS, LDS_BYTES);
    (void)hipGetLastError();
    if (cus != 256 || per_cu < 1) { fprintf(stderr, "kernel_launch: needs a 256-CU device with one resident workgroup per CU (cus %d, per_cu %d)\n", cus, per_cu); grid = -1; return; }
    grid = 256;
  }
  if (grid < 0) return;
  (void)hipMemsetAsync((char*)d_ws + O_CTL, 0, CTL_BYTES, stream);
  Args a{};
  for (int i = 0; i < 22; ++i) a.in[i] = (const float*)d_in[i];
  a.out = (float*)d_out; a.ws = (unsigned char*)d_ws;
#if ONE_LAUNCH
  a.ph_lo = 0; a.ph_hi = HYBRID_CUT;
  hipLaunchKernelGGL(fwd_kernel, dim3(grid), dim3(NTHREADS), LDS_BYTES, stream, a);
#else
#ifdef PHASE_SEQ
  { const int seq[] = {PHASE_SEQ}; for (int i = 0; i < (int)(sizeof(seq) / sizeof(int)); ++i) { a.ph_lo = seq[i]; a.ph_hi = seq[i] + 1; (void)hipMemsetAsync((char*)d_ws + O_CTL, 0, CTL_BYTES, stream); hipLaunchKernelGGL(fwd_kernel, dim3(grid), dim3(NTHREADS), LDS_BYTES, stream, a); } }
#else
  for (int p = 0; p < HYBRID_CUT; ++p) { a.ph_lo = p; a.ph_hi = p + 1; hipLaunchKernelGGL(fwd_kernel, dim3(grid), dim3(NTHREADS), LDS_BYTES, stream, a); }
#endif
#endif
#if HYBRID_CUT < 9
  float* h = (float*)d_out;
  if (HYBRID_CUT <= 5) slow_xattn(stream, d_in, h, (float*)d_ws);
  slow_peer(stream, d_in, h, (float*)d_ws, (float*)d_out);
#endif
}
```

```cpp
#define HYBRID_CUT 9
#define ONE_LAUNCH 1
#include <hip/hip_runtime.h>
#include <cstdio>
#include <math.h>

#define LAS __attribute__((address_space(3)))
typedef _Float16 h16;
typedef _Float16 half8 __attribute__((ext_vector_type(8)));
typedef _Float16 half4 __attribute__((ext_vector_type(4)));
typedef _Float16 half2v __attribute__((ext_vector_type(2)));
typedef float f32x4 __attribute__((ext_vector_type(4)));
typedef float f32x2 __attribute__((ext_vector_type(2)));
typedef unsigned u32x4 __attribute__((ext_vector_type(4)));
typedef unsigned u32x2 __attribute__((ext_vector_type(2)));

constexpr int T_ = 16384, D_ = 2048, SEQ_ = 8192;
constexpr float EPS_ = 1e-6f;
constexpr size_t MiB = 1ull << 20;
constexpr size_t O_W1T   = 0;
constexpr size_t O_W3T   = O_W1T   + 12 * MiB;
constexpr size_t O_WKVT  = O_W3T   + 8 * MiB;
constexpr size_t O_WQ16  = O_WKVT  + 16 * MiB;
constexpr size_t O_WOT   = O_WQ16  + 8 * MiB;
constexpr size_t O_WQRY  = O_WOT   + 8 * MiB;
constexpr size_t O_WQST  = O_WQRY  + 8 * MiB;
constexpr size_t O_WQKT  = O_WQST  + 8 * MiB;
constexpr size_t O_WVOT  = O_WQKT  + 8 * MiB;
constexpr size_t O_WINZ  = O_WVOT  + 8 * MiB;
constexpr size_t O_WPOOLT= O_WINZ  + 4 * MiB;
constexpr size_t O_SKBD  = O_WPOOLT+ 1 * MiB;
constexpr size_t O_WSGU  = O_SKBD  + 1 * MiB;
constexpr size_t O_M16   = O_WSGU  + 1 * MiB;
constexpr size_t O_KV16  = O_M16   + 2 * MiB;
constexpr size_t O_U8    = O_KV16  + 4 * MiB;
constexpr size_t O_V8    = O_U8    + 32 * MiB;
constexpr size_t O_SU    = O_V8    + 32 * MiB;
constexpr size_t O_SV    = O_SU    + 1 * MiB;
constexpr size_t O_RSTD1 = O_SV    + 1 * MiB;
constexpr size_t O_LNST  = O_RSTD1 + 1 * MiB;
constexpr size_t O_SSQ2  = O_LNST  + 2 * MiB;
constexpr size_t O_SSQ3  = O_SSQ2  + 2 * MiB;
constexpr size_t O_CTL   = O_SSQ3  + 2 * MiB;
constexpr size_t O_X16   = O_CTL   + 1 * MiB;
constexpr size_t O_RA    = O_X16   + 64 * MiB;
constexpr size_t O_RB    = O_RA    + 64 * MiB;
constexpr size_t WS_END  = O_RB    + 128 * MiB;
constexpr size_t CTL_BYTES = 64 * 1024;

constexpr int LDS_BYTES = 144 * 1024;
constexpr int NTHREADS = 512;

__device__ __forceinline__ float wave_sum(float v) {
  v += __builtin_bit_cast(float, __builtin_amdgcn_update_dpp(0, __builtin_bit_cast(int, v), 0xB1, 0xf, 0xf, true));
  v += __builtin_bit_cast(float, __builtin_amdgcn_update_dpp(0, __builtin_bit_cast(int, v), 0x4E, 0xf, 0xf, true));
  v += __builtin_bit_cast(float, __builtin_amdgcn_update_dpp(0, __builtin_bit_cast(int, v), 0x141, 0xf, 0xf, true));
  v += __builtin_bit_cast(float, __builtin_amdgcn_update_dpp(0, __builtin_bit_cast(int, v), 0x140, 0xf, 0xf, true));
  v += __builtin_bit_cast(float, __builtin_amdgcn_update_dpp(0, __builtin_bit_cast(int, v), 0x142, 0xa, 0xf, false));
  v += __builtin_bit_cast(float, __builtin_amdgcn_update_dpp(0, __builtin_bit_cast(int, v), 0x143, 0xc, 0xf, false));
  return __builtin_bit_cast(float, __builtin_amdgcn_readlane(__builtin_bit_cast(int, v), 63));
}
__device__ __forceinline__ float wave_max(float v) {
  for (int o = 32; o >= 1; o >>= 1) v = fmaxf(v, __shfl_xor(v, o));
  return v;
}
__device__ __forceinline__ unsigned pk_h2(float lo, float hi) { half2v r; r.x = (h16)lo; r.y = (h16)hi; return __builtin_bit_cast(unsigned, r); }
__device__ __forceinline__ float gelu_f(float v) { return 0.5f * v * (1.0f + erff(v * 0.70710678118654752f)); }
__device__ __forceinline__ f32x2 gelu_pk(f32x2 v) {
    const f32x2 av = __builtin_elementwise_abs(v), d = av * 0.2316418882f + 1.0f;
    f32x2 t; t.x = __builtin_amdgcn_rcpf(d.x); t.y = __builtin_amdgcn_rcpf(d.y);
    f32x2 q = t * 0.5307027145f + (-0.7265760135f); q = q * t + 0.7107068705f; q = q * t + (-0.142248368f); q = q * t + 0.127414796f; q = q * t;
    const f32x2 s = (v * v) * (-0.72134752044f);
    f32x2 e; e.x = __builtin_amdgcn_exp2f(s.x); e.y = __builtin_amdgcn_exp2f(s.y);
    const f32x2 m = v * (q * e), r = v - m;
    f32x2 o; o.x = v.x < 0.f ? m.x : r.x; o.y = v.y < 0.f ? m.y : r.y; return o;
}
namespace pg {
constexpr int BM = 256, BK = 64, HALF = 128, HTB = HALF * BK * 2, STAGE_BYTES = 8 * HTB, NXCD = 8, WGM = 8;

__host__ __device__ __forceinline__ int lds_byte(int r, int c) { const int st = (r >> 4) * 2 + (c >> 5), rr = r & 15, cc = c & 31, ob = rr * 64 + cc * 2; return st * 1024 + (ob ^ (((ob >> 9) & 1) << 5)); }
__host__ __device__ __forceinline__ void stage_rc(int b, int& R, int& C) { const int st = b / 1024, sb = b % 1024, swz = sb ^ (((sb >> 9) & 1) << 5); R = (st >> 1) * 16 + swz / 64; C = (st & 1) * 32 + (swz % 64) / 2; }
__host__ __device__ __forceinline__ int perm32(int rho) { const int n = rho >> 4, i = rho & 15; return 8 * (i >> 2) + 4 * n + (i & 3); }

struct Unit { int pm, pn; };
struct Gemm { const h16* A; const h16* Bt; int lda, ldb, K, bdiv; long bstride; int ablk; };

struct StaticOrder {
    int nM, nN, nwg, G, c;
    __device__ void init(int nM_, int nN_, int G_, int c_) { nM = nM_; nN = nN_; nwg = nM * nN; G = G_; c = c_; }
    __device__ bool next(int i, Unit& u) const {
        const long L = (long)i * G + c; if (L >= nwg) return false;
        int wgid = (int)L; { const int q = nwg / NXCD, r = nwg % NXCD, xcd = wgid % NXCD, off = wgid / NXCD; wgid = (xcd < r ? xcd * (q + 1) : r * (q + 1) + (xcd - r) * q) + off; }
        const int nig = WGM * nN, gid = wgid / nig, fm = gid * WGM, gsz = (nM - fm) < WGM ? (nM - fm) : WGM;
        u.pm = fm + ((wgid % nig) % gsz); u.pn = (wgid % nig) / gsz; return true;
    }
};
struct OneUnit { Unit u; __device__ bool next(int i, Unit& o) const { if (i != 0) return false; o = u; return true; } };

typedef f32x4 Acc[2][2][4][2];

template <class Epi, class Sched, bool ALIGN_EPI = true, bool SP2 = true, int NREP = 1>
__device__ __forceinline__ void gemm_phase(LAS unsigned char* lds, const Gemm g, const Sched& S, const Epi& E) {
    const int tid = threadIdx.x, wid = __builtin_amdgcn_readfirstlane(tid >> 6), lane = tid & 63, wr = wid >> 2, wc = wid & 3, fr = lane & 15, fq = lane >> 4;
    const int K = g.K, nt = K / BK;
    unsigned voffA[2], voffB[2];
#pragma unroll
    for (int i = 0; i < 2; ++i) { int R, C; stage_rc(tid * 16 + i * 8192, R, C); const int Rb = Epi::PERM ? ((R & ~31) + perm32(R & 31)) : R;
        voffA[i] = g.ablk ? (unsigned)((((R >> 4) * (g.lda >> 5) + (C >> 5)) * 512 + (R & 15) * 32 + (C & 31))) * 2u : (unsigned)(R * g.lda + C) * 2u; voffB[i] = (unsigned)(Rb * g.ldb + C) * 2u; }
    const size_t kstep = (size_t)(BK * 2), kstepA = g.ablk ? (size_t)2048 : kstep;
    const size_t hstepA = (size_t)HALF * g.lda * 2, hstepB = (size_t)HALF * g.ldb * 2;
    const size_t tstepA = 2 * hstepA, tstepB = 2 * hstepB;
    const unsigned ldsw = (unsigned)wid * 1024u;
    const int aoff = lds_byte(wr * 64 + fr, fq * 8), boff = lds_byte(wc * 32 + fr, fq * 8);
#define PG_SA(b, h) (((b) * 2 + (h)) * HTB)
#define PG_SB(b, h) ((4 + (b) * 2 + (h)) * HTB)
#define PG_STAGE(bufoff, gbase, voff) do { _Pragma("unroll") for (int _i = 0; _i < 2; ++_i) \
        __builtin_amdgcn_global_load_lds((const unsigned*)((const char*)(gbase) + (voff)[_i]), (LAS unsigned*)(lds + (bufoff) + ldsw + _i * 8192), 16, 0, 0); } while (0)
#define PG_LDA(dst, b, h) do { _Pragma("unroll") for (int m = 0; m < 4; ++m) _Pragma("unroll") for (int k = 0; k < 2; ++k) dst[m][k] = *(const LAS half8*)(lds + PG_SA(b, h) + aoff + m * 2048 + k * 1024); } while (0)
#define PG_LDB(dst, b, h) do { _Pragma("unroll") for (int n = 0; n < 2; ++n) _Pragma("unroll") for (int k = 0; k < 2; ++k) dst[n][k] = *(const LAS half8*)(lds + PG_SB(b, h) + boff + n * 2048 + k * 1024); } while (0)
#define PG_MMA(ai, bj, At, Bt) do { __builtin_amdgcn_s_setprio(1); _Pragma("unroll") for (int m = 0; m < 4; ++m) _Pragma("unroll") for (int n = 0; n < 2; ++n) _Pragma("unroll") for (int k = 0; k < 2; ++k) \
        acc[ai][bj][m][n] = __builtin_amdgcn_mfma_f32_16x16x32_f16(Bt[n][k], At[m][k], acc[ai][bj][m][n], 0, 0, 0); __builtin_amdgcn_s_setprio(0); } while (0)
#define PG_WAIT_V(n) asm volatile("s_waitcnt vmcnt(" #n ")" ::: "memory")
#define PG_WAIT_L(n) asm volatile("s_waitcnt lgkmcnt(" #n ")" ::: "memory")
#define PG_BAR __builtin_amdgcn_s_barrier()
#define PG_SCHED __builtin_amdgcn_sched_barrier(0)
    Unit cur, nxt; int ui = 0;
    if (!S.next(0, cur)) return;
    f32x4 acc[2][2][4][2];
#pragma unroll
    for (int a = 0; a < 2; ++a)
#pragma unroll
        for (int b = 0; b < 2; ++b)
#pragma unroll
            for (int m = 0; m < 4; ++m)
#pragma unroll
                for (int n = 0; n < 2; ++n) acc[a][b][m][n] = (f32x4){0.f, 0.f, 0.f, 0.f};
    half8 At[4][2], B0[2][2], B1[2][2];
    const char* cA = (const char*)g.A + (size_t)cur.pm * tstepA;
    const char* cB = (const char*)(g.Bt + (size_t)(cur.pm / g.bdiv) * g.bstride) + (size_t)cur.pn * tstepB;
    if constexpr (SP2) {
        PG_STAGE(PG_SB(0, 0), cB, voffB); PG_STAGE(PG_SB(0, 1), cB + hstepB, voffB); PG_STAGE(PG_SA(0, 0), cA, voffA); PG_STAGE(PG_SA(0, 1), cA + hstepA, voffA);
        if (wr == 1) PG_BAR;
        PG_WAIT_V(2); PG_BAR;
        PG_STAGE(PG_SB(1, 0), cB + kstep, voffB); PG_STAGE(PG_SA(1, 0), cA + kstepA, voffA); PG_STAGE(PG_SB(1, 1), cB + hstepB + kstep, voffB);
        PG_WAIT_V(6); PG_BAR;
    } else {
        PG_STAGE(PG_SB(0, 0), cB, voffB); PG_STAGE(PG_SA(0, 0), cA, voffA); PG_STAGE(PG_SB(0, 1), cB + hstepB, voffB); PG_STAGE(PG_SA(0, 1), cA + hstepA, voffA);
        if (wr == 1) PG_BAR;
        PG_WAIT_V(4); PG_BAR;
        PG_STAGE(PG_SB(1, 0), cB + kstep, voffB); PG_STAGE(PG_SA(1, 0), cA + kstepA, voffA); PG_STAGE(PG_SB(1, 1), cB + hstepB + kstep, voffB);
        PG_WAIT_V(6); PG_BAR;
    }
    for (;;) {
        const bool has_next = S.next(ui + 1, nxt);
        const char* nA = has_next ? (const char*)g.A + (size_t)nxt.pm * tstepA : cA;
        const char* nB = has_next ? (const char*)(g.Bt + (size_t)(nxt.pm / g.bdiv) * g.bstride) + (size_t)nxt.pn * tstepB : cB;
        for (int rep = 0; rep < NREP; ++rep) {
        const char* nAe = (rep < NREP - 1) ? cA : nA; const char* nBe = (rep < NREP - 1) ? cB : nB;
        for (int t = 0; t < nt; t += 2) {
            const bool last = (t == nt - 2);
            const char* a1 = cA + (size_t)(t + 1) * kstepA;
            const char* a2 = last ? nAe : cA + (size_t)(t + 2) * kstepA; const char* b2 = last ? nBe : cB + (size_t)(t + 2) * kstep;
            const char* a3 = a2 + kstepA; const char* b3 = b2 + kstep;
            if constexpr (SP2) {
            PG_LDB(B0, 0, 0); PG_LDB(B1, 0, 1); PG_SCHED; PG_LDA(At, 0, 0); PG_STAGE(PG_SA(1, 1), a1 + hstepA, voffA);
            PG_WAIT_V(8); PG_WAIT_L(0); PG_BAR; PG_MMA(0, 0, At, B0); PG_MMA(0, 1, At, B1); PG_BAR; PG_SCHED;
            PG_LDA(At, 0, 1); PG_STAGE(PG_SB(0, 0), b2, voffB); PG_STAGE(PG_SB(0, 1), b2 + hstepB, voffB); PG_STAGE(PG_SA(0, 0), a2, voffA);
            PG_WAIT_V(8); PG_WAIT_L(0); PG_BAR; PG_MMA(1, 0, At, B0); PG_MMA(1, 1, At, B1); PG_BAR; PG_SCHED;
            PG_LDB(B0, 1, 0); PG_LDB(B1, 1, 1); PG_SCHED; PG_LDA(At, 1, 0); PG_STAGE(PG_SA(0, 1), a2 + hstepA, voffA);
            PG_WAIT_V(8); PG_WAIT_L(0); PG_BAR; PG_MMA(0, 0, At, B0); PG_MMA(0, 1, At, B1); PG_BAR; PG_SCHED;
            PG_LDA(At, 1, 1); PG_STAGE(PG_SB(1, 0), b3, voffB); PG_STAGE(PG_SB(1, 1), b3 + hstepB, voffB); PG_STAGE(PG_SA(1, 0), a3, voffA);
            PG_WAIT_V(8); PG_WAIT_L(0); PG_BAR; PG_MMA(1, 0, At, B0); PG_MMA(1, 1, At, B1); PG_BAR; PG_SCHED;
            } else {
            PG_LDB(B0, 0, 0); PG_SCHED; PG_LDA(At, 0, 0); PG_STAGE(PG_SA(1, 1), a1 + hstepA, voffA);
            PG_WAIT_L(8); PG_BAR; PG_WAIT_L(0); PG_MMA(0, 0, At, B0); PG_BAR; PG_SCHED;
            PG_LDB(B1, 0, 1); PG_STAGE(PG_SB(0, 0), b2, voffB);
            PG_BAR; PG_WAIT_L(0); PG_MMA(0, 1, At, B1); PG_BAR;
            PG_LDA(At, 0, 1); PG_STAGE(PG_SA(0, 0), a2, voffA);
            PG_BAR; PG_WAIT_L(0); PG_MMA(1, 0, At, B0); PG_BAR; PG_SCHED;
            PG_STAGE(PG_SB(0, 1), b2 + hstepB, voffB);
            PG_WAIT_V(6); PG_BAR; PG_MMA(1, 1, At, B1); PG_BAR;
            PG_LDB(B0, 1, 0); PG_SCHED; PG_LDA(At, 1, 0); PG_STAGE(PG_SA(0, 1), a2 + hstepA, voffA);
            PG_WAIT_L(8); PG_BAR; PG_WAIT_L(0); PG_MMA(0, 0, At, B0); PG_BAR; PG_SCHED;
            PG_LDB(B1, 1, 1); PG_STAGE(PG_SB(1, 0), b3, voffB);
            PG_BAR; PG_WAIT_L(0); PG_MMA(0, 1, At, B1); PG_BAR;
            PG_LDA(At, 1, 1); PG_STAGE(PG_SA(1, 0), a3, voffA);
            PG_BAR; PG_WAIT_L(0); PG_MMA(1, 0, At, B0); PG_BAR; PG_SCHED;
            PG_STAGE(PG_SB(1, 1), b3 + hstepB, voffB);
            PG_WAIT_V(6); PG_BAR; PG_MMA(1, 1, At, B1); PG_BAR;
                    }
        }
        if (rep < NREP - 1) {
#pragma unroll
          for (int a = 0; a < 2; ++a)
#pragma unroll
            for (int b = 0; b < 2; ++b)
#pragma unroll
              for (int m = 0; m < 4; ++m)
#pragma unroll
                for (int n = 0; n < 2; ++n) acc[a][b][m][n] = (f32x4){0.f, 0.f, 0.f, 0.f}; }
        }
        if constexpr (ALIGN_EPI) { if (wr == 0) PG_BAR; }
        if constexpr (!Epi::AFTER_DRAIN) { E(acc, cur, wr, wc, fr, fq, lds + STAGE_BYTES); }
        if (!has_next) break;
#pragma unroll
        for (int a = 0; a < 2; ++a)
#pragma unroll
            for (int b = 0; b < 2; ++b)
#pragma unroll
                for (int m = 0; m < 4; ++m)
#pragma unroll
                    for (int n = 0; n < 2; ++n) acc[a][b][m][n] = (f32x4){0.f, 0.f, 0.f, 0.f};
        cur = nxt; cA = nA; cB = nB; ++ui;
        if constexpr (ALIGN_EPI) { if (wr == 1) PG_BAR; }
    }
    PG_WAIT_V(0);
    if constexpr (!ALIGN_EPI) { if (wr == 0) PG_BAR; }
    PG_BAR;
    if constexpr (Epi::AFTER_DRAIN) { E.fused(acc, cur, wr, wc, fr, fq, lds); }
#undef PG_SA
#undef PG_SB
#undef PG_STAGE
#undef PG_LDA
#undef PG_LDB
#undef PG_MMA
#undef PG_WAIT_V
#undef PG_WAIT_L
#undef PG_BAR
#undef PG_SCHED
}
}
namespace pg {
__device__ __forceinline__ size_t blk_off(int r, int c, int C) { return ((size_t)((r >> 4) * (C >> 5) + (c >> 5))) * 512 + (size_t)((r & 15) * 32 + (c & 31)); }
struct EpiHalf {
    static constexpr bool PERM = true, AFTER_DRAIN = false;
    h16* O; int ldc;
    __device__ __forceinline__ void operator()(const Acc& acc, const Unit& u, int wr, int wc, int fr, int fq, LAS unsigned char*) const {
        const int row0 = u.pm * BM + wr * 64 + fr, col0 = u.pn * BM + wc * 32 + 8 * fq;
#pragma unroll
        for (int ai = 0; ai < 2; ++ai)
#pragma unroll
            for (int m = 0; m < 4; ++m) { h16* rowp = O + (size_t)(row0 + ai * HALF + m * 16) * ldc + col0;
#pragma unroll
                for (int bj = 0; bj < 2; ++bj) { const f32x4 v0 = acc[ai][bj][m][0], v1 = acc[ai][bj][m][1];
                    u32x4 w; w.x = pk_h2(v0[0], v0[1]); w.y = pk_h2(v0[2], v0[3]); w.z = pk_h2(v1[0], v1[1]); w.w = pk_h2(v1[2], v1[3]);
                    *(u32x4*)(rowp + bj * HALF) = w; } }
    }
};
struct Epi1 {
    static constexpr bool PERM = true, AFTER_DRAIN = false;
    const float* rstd1; h16* UVZ; f32x2* lnst;
    __device__ __forceinline__ void operator()(const Acc& acc, const Unit& u, int wr, int wc, int fr, int fq, LAS unsigned char*) const {
        const int seg = u.pn >> 2, pnl = u.pn & 3;
        h16* base = UVZ + (size_t)seg * (16u << 20);
        const int row0 = u.pm * BM + wr * 64 + fr, col0 = pnl * BM + wc * 32 + 8 * fq;
#pragma unroll
        for (int ai = 0; ai < 2; ++ai)
#pragma unroll
            for (int m = 0; m < 4; ++m) { const int row = row0 + ai * HALF + m * 16; const float rs = rstd1[row]; h16* rowp = base + (size_t)row * 1024 + col0;
                float s = 0.f, ss = 0.f;
#pragma unroll
                for (int bj = 0; bj < 2; ++bj) { f32x4 v0 = acc[ai][bj][m][0] * rs, v1 = acc[ai][bj][m][1] * rs;
                    if (seg < 2) { f32x2 a = gelu_pk((f32x2){v0[0], v0[1]}), b = gelu_pk((f32x2){v0[2], v0[3]}), c = gelu_pk((f32x2){v1[0], v1[1]}), d = gelu_pk((f32x2){v1[2], v1[3]});
                        v0 = (f32x4){a.x, a.y, b.x, b.y}; v1 = (f32x4){c.x, c.y, d.x, d.y}; }
                    if (seg == 1) { s += (v0[0] + v0[1]) + (v0[2] + v0[3]) + (v1[0] + v1[1]) + (v1[2] + v1[3]);
                        ss += (v0[0] * v0[0] + v0[1] * v0[1]) + (v0[2] * v0[2] + v0[3] * v0[3]) + (v1[0] * v1[0] + v1[1] * v1[1]) + (v1[2] * v1[2] + v1[3] * v1[3]); }
                    u32x4 w; w.x = pk_h2(v0[0], v0[1]); w.y = pk_h2(v0[2], v0[3]); w.z = pk_h2(v1[0], v1[1]); w.w = pk_h2(v1[2], v1[3]);
                    *(u32x4*)(rowp + bj * HALF) = w; }
                if (seg == 1) { s += __shfl_xor(s, 16); s += __shfl_xor(s, 32); ss += __shfl_xor(ss, 16); ss += __shfl_xor(ss, 32);
                    if (fq == 0) lnst[(size_t)row * 16 + pnl * 4 + wc] = (f32x2){s, ss}; } }
    }
};
template <bool RES_BLK>
struct EpiRes {
    static constexpr bool PERM = true, AFTER_DRAIN = false;
    const h16* res; h16* o16; float* ssq;
    __device__ __forceinline__ void operator()(const Acc& acc, const Unit& u, int wr, int wc, int fr, int fq, LAS unsigned char*) const {
        const int row0 = u.pm * BM + wr * 64 + fr, col0 = u.pn * BM + wc * 32 + 8 * fq;
        const h16* rb = res + (RES_BLK ? blk_off(row0, col0, 2048) : (size_t)row0 * 2048 + col0);
        h16* ob = o16 + blk_off(row0, col0, 2048);
        half8 r[2][4][2];
#pragma unroll
        for (int ai = 0; ai < 2; ++ai)
#pragma unroll
            for (int m = 0; m < 4; ++m)
#pragma unroll
                for (int bj = 0; bj < 2; ++bj) r[ai][m][bj] = *(const half8*)(rb + (RES_BLK ? (size_t)(((8 * ai + m) * 64 + 4 * bj) * 512) : (size_t)(ai * HALF + m * 16) * 2048 + bj * HALF));
#pragma unroll
        for (int ai = 0; ai < 2; ++ai)
#pragma unroll
            for (int m = 0; m < 4; ++m) { const int row = row0 + ai * HALF + m * 16; float q = 0.f;
#pragma unroll
                for (int bj = 0; bj < 2; ++bj) { const half8 rr = r[ai][m][bj];
                    const f32x4 v0 = acc[ai][bj][m][0] + (f32x4){(float)rr[0], (float)rr[1], (float)rr[2], (float)rr[3]}, v1 = acc[ai][bj][m][1] + (f32x4){(float)rr[4], (float)rr[5], (float)rr[6], (float)rr[7]};
                    u32x4 w; w.x = pk_h2(v0[0], v0[1]); w.y = pk_h2(v0[2], v0[3]); w.z = pk_h2(v1[0], v1[1]); w.w = pk_h2(v1[2], v1[3]);
                    *(u32x4*)(ob + (size_t)(((8 * ai + m) * 64 + 4 * bj) * 512)) = w;
                    q += (v0[0] * v0[0] + v0[1] * v0[1]) + (v0[2] * v0[2] + v0[3] * v0[3]) + (v1[0] * v1[0] + v1[1] * v1[1]) + (v1[2] * v1[2] + v1[3] * v1[3]); }
                q += __shfl_xor(q, 16); q += __shfl_xor(q, 32);
                if (fq == 0) ssq[(size_t)row * 32 + u.pn * 4 + wc] = q; }
    }
};
__device__ __forceinline__ void rows_rstd(const float* ssq, int row0, int fq, float (&rs)[2][4]) {
    f32x4 a[2][4], b[2][4];
#pragma unroll
    for (int ai = 0; ai < 2; ++ai)
#pragma unroll
        for (int m = 0; m < 4; ++m) { const float* p = ssq + (size_t)(row0 + ai * HALF + m * 16) * 32 + fq * 8; a[ai][m] = *(const f32x4*)p; b[ai][m] = *(const f32x4*)(p + 4); }
#pragma unroll
    for (int ai = 0; ai < 2; ++ai)
#pragma unroll
        for (int m = 0; m < 4; ++m) { float q = ((a[ai][m][0] + a[ai][m][1]) + (a[ai][m][2] + a[ai][m][3])) + ((b[ai][m][0] + b[ai][m][1]) + (b[ai][m][2] + b[ai][m][3]));
            q += __shfl_xor(q, 16); q += __shfl_xor(q, 32); rs[ai][m] = rsqrtf(q * (1.0f / 2048.0f) + EPS_); }
}
__device__ __forceinline__ float row_rstd(const float* ssq, int row, int fq) {
    const float* p = ssq + (size_t)row * 32 + fq * 8; const f32x4 a = *(const f32x4*)p, b = *(const f32x4*)(p + 4);
    float q = ((a[0] + a[1]) + (a[2] + a[3])) + ((b[0] + b[1]) + (b[2] + b[3]));
    q += __shfl_xor(q, 16); q += __shfl_xor(q, 32);
    return rsqrtf(q * (1.0f / 2048.0f) + EPS_);
}
struct EpiSoftmax {
    static constexpr bool PERM = true, AFTER_DRAIN = true;
    const float* ssq2; h16* P;
    __device__ __forceinline__ void fused(Acc& acc, const Unit& u, int wr, int wc, int fr, int fq, LAS unsigned char* lds) const {
        LAS f32x2* X = (LAS f32x2*)lds;
        float mxs[2][4], rsv[2][4];
        rows_rstd(ssq2, u.pm * BM + wr * 64 + fr, fq, rsv);
#pragma unroll
        for (int ai = 0; ai < 2; ++ai)
#pragma unroll
            for (int m = 0; m < 4; ++m) { const int rl = ai * HALF + wr * 64 + m * 16 + fr;
                const float rs = rsv[ai][m] * 0.044194173824159216f;
                float mx = -INFINITY;
#pragma unroll
                for (int bj = 0; bj < 2; ++bj)
#pragma unroll
                    for (int n = 0; n < 2; ++n) { f32x4 v = acc[ai][bj][m][n] * rs; acc[ai][bj][m][n] = v; mx = fmaxf(mx, fmaxf(fmaxf(v[0], v[1]), fmaxf(v[2], v[3]))); }
                mx = fmaxf(mx, __shfl_xor(mx, 16)); mx = fmaxf(mx, __shfl_xor(mx, 32));
                float l = 0.f;
#pragma unroll
                for (int bj = 0; bj < 2; ++bj)
#pragma unroll
                    for (int n = 0; n < 2; ++n) { f32x4 v = acc[ai][bj][m][n]; v[0] = __expf(v[0] - mx); v[1] = __expf(v[1] - mx); v[2] = __expf(v[2] - mx); v[3] = __expf(v[3] - mx);
                        acc[ai][bj][m][n] = v; l += (v[0] + v[1]) + (v[2] + v[3]); }
                l += __shfl_xor(l, 16); l += __shfl_xor(l, 32);
                if (fq == 0) X[rl * 4 + wc] = (f32x2){mx, l};
                mxs[ai][m] = mx; }
        asm volatile("s_waitcnt lgkmcnt(0)" ::: "memory"); __builtin_amdgcn_s_barrier(); asm volatile("" ::: "memory");
        const int col0 = u.pn * BM + wc * 32 + 8 * fq;
#pragma unroll
        for (int ai = 0; ai < 2; ++ai)
#pragma unroll
            for (int m = 0; m < 4; ++m) { const int rl = ai * HALF + wr * 64 + m * 16 + fr; const int row = u.pm * BM + rl;
                const f32x2 x0 = X[rl * 4 + 0], x1 = X[rl * 4 + 1], x2 = X[rl * 4 + 2], x3 = X[rl * 4 + 3];
                const float M = fmaxf(fmaxf(x0.x, x1.x), fmaxf(x2.x, x3.x));
                const float L = x0.y * __expf(x0.x - M) + x1.y * __expf(x1.x - M) + x2.y * __expf(x2.x - M) + x3.y * __expf(x3.x - M);
                const float f = __expf(mxs[ai][m] - M) / L;
#pragma unroll
                for (int bj = 0; bj < 2; ++bj) { const f32x4 v0 = acc[ai][bj][m][0] * f, v1 = acc[ai][bj][m][1] * f;
                    u32x4 w; w.x = pk_h2(v0[0], v0[1]); w.y = pk_h2(v0[2], v0[3]); w.z = pk_h2(v1[0], v1[1]); w.w = pk_h2(v1[2], v1[3]);
                    *(u32x4*)(P + blk_off(u.pm * BM + wr * 64 + fr, col0, 1024) + (size_t)(((8 * ai + m) * 32 + 4 * bj) * 512)) = w; } }
    }
};
struct EpiScore {
    static constexpr bool PERM = false, AFTER_DRAIN = false;
    const float* ssq3; h16* S;
    __device__ __forceinline__ void operator()(const Acc& acc, const Unit& u, int wr, int wc, int fr, int fq, LAS unsigned char*) const {
        const int row0 = u.pm * BM + wr * 64 + fr, col0 = u.pn * BM + wc * 32 + 4 * fq;
        float rsv[2][4]; rows_rstd(ssq3, row0, fq, rsv);
        h16* sb = S + ((size_t)((row0 >> 4) * 128 + (col0 >> 4))) * 256 + (size_t)((row0 & 15) * 16 + (col0 & 15));
#pragma unroll
        for (int ai = 0; ai < 2; ++ai)
#pragma unroll
            for (int m = 0; m < 4; ++m) { const float rs = rsv[ai][m];
#pragma unroll
                for (int bj = 0; bj < 2; ++bj)
#pragma unroll
                    for (int n = 0; n < 2; ++n) { const f32x4 v = acc[ai][bj][m][n] * rs; *(u32x2*)(sb + (size_t)(((8 * ai + m) * 128 + 8 * bj + n) * 256)) = (u32x2){pk_h2(v[0], v[1]), pk_h2(v[2], v[3])}; } }
    }
};
}

__device__ __forceinline__ void conv_trans_tile(const float* __restrict__ src, int ldsrc, int k0, int n0, h16* __restrict__ dst, int lddst, const float* __restrict__ rs, int rs_off, LAS unsigned char* lds) {
  LAS h16* tile = (LAS h16*)lds;
  const int tid = threadIdx.x;
  const int c4 = tid & 31, r = tid >> 5;
  f32x4 v[4];
#pragma unroll
  for (int p = 0; p < 4; ++p) v[p] = *(const f32x4*)(src + (size_t)(k0 + r + 16 * p) * ldsrc + n0 + c4 * 4);
  __syncthreads();
#pragma unroll
  for (int p = 0; p < 4; ++p) { const int k = r + 16 * p; float s = 1.0f; if (rs) { int kk = k0 + k + rs_off; s = kk >= 0 ? rs[kk] : 1.0f; }
#pragma unroll
    for (int j = 0; j < 4; ++j) tile[(c4 * 4 + j) * 72 + k] = (h16)(v[p][j] * s); }
  __syncthreads();
#pragma unroll
  for (int p = 0; p < 2; ++p) { const int n = (tid >> 3) + 64 * p, k8 = (tid & 7) * 8;
    const u32x4 w = *(const LAS u32x4*)(tile + n * 72 + k8);
    *(u32x4*)(dst + (size_t)(n0 + n) * lddst + k0 + k8) = w; }
}
__device__ __forceinline__ void conv_copy_rows(const float* __restrict__ src, int ldsrc, int r0, int rows, int cols, h16* __restrict__ dst, int lddst, const float* __restrict__ rs) {
  const int per_row = cols >> 3, total = rows * per_row;
  for (int i = threadIdx.x; i < total; i += NTHREADS) { const int r = r0 + i / per_row, c = (i % per_row) * 8;
    const float s = rs ? rs[r] : 1.0f;
    const f32x4 a = *(const f32x4*)(src + (size_t)r * ldsrc + c), b = *(const f32x4*)(src + (size_t)r * ldsrc + c + 4);
    u32x4 w; w.x = pk_h2(a[0] * s, a[1] * s); w.y = pk_h2(a[2] * s, a[3] * s); w.z = pk_h2(b[0] * s, b[1] * s); w.w = pk_h2(b[2] * s, b[3] * s);
    *(u32x4*)(dst + (size_t)r * lddst + c) = w; }
}
__device__ __forceinline__ void conv_rows_norm(const float* __restrict__ x, int row0, h16* __restrict__ x16, float* __restrict__ rstd_out, const float* __restrict__ g) {
  const int lane = threadIdx.x & 63, rowa = row0 + 2 * (threadIdx.x >> 6);
  f32x4 a[2][4], b[2][4];
#pragma unroll
  for (int rr = 0; rr < 2; ++rr) { const float* xr = x + (size_t)(rowa + rr) * 2048;
#pragma unroll
    for (int j = 0; j < 4; ++j) { a[rr][j] = *(const f32x4*)(xr + (j * 64 + lane) * 8); b[rr][j] = *(const f32x4*)(xr + (j * 64 + lane) * 8 + 4); } }
#pragma unroll
  for (int rr = 0; rr < 2; ++rr) { const int row = rowa + rr; float ss = 0.f;
#pragma unroll
    for (int j = 0; j < 4; ++j) ss += (a[rr][j][0] * a[rr][j][0] + a[rr][j][1] * a[rr][j][1]) + (a[rr][j][2] * a[rr][j][2] + a[rr][j][3] * a[rr][j][3]) + (b[rr][j][0] * b[rr][j][0] + b[rr][j][1] * b[rr][j][1]) + (b[rr][j][2] * b[rr][j][2] + b[rr][j][3] * b[rr][j][3]);
    ss = wave_sum(ss);
    const float r = rsqrtf(ss * (1.0f / 2048.0f) + EPS_);
    if (rstd_out && lane == 0) rstd_out[row] = r;
#pragma unroll
    for (int j = 0; j < 4; ++j) { f32x4 p = a[rr][j], q = b[rr][j];
      if (g) { const f32x4 g0 = *(const f32x4*)(g + (j * 64 + lane) * 8), g1 = *(const f32x4*)(g + (j * 64 + lane) * 8 + 4); p = p * g0 * r; q = q * g1 * r; }
      u32x4 w; w.x = pk_h2(p[0], p[1]); w.y = pk_h2(p[2], p[3]); w.z = pk_h2(q[0], q[1]); w.w = pk_h2(q[2], q[3]);
      *(u32x4*)(x16 + (size_t)row * 2048 + (j * 64 + lane) * 8) = w; } }
}
constexpr unsigned T4_V = 1024u, T4_SC = 2048u, T4_EXP = 2176u;
__device__ __forceinline__ void conv_table_rows(const float* __restrict__ tab, int row0, unsigned char* __restrict__ t4, float* __restrict__ sc, int which) {
  const int lane = threadIdx.x & 63, rowa = row0 + 2 * (threadIdx.x >> 6);
  f32x4 a[2][4], b[2][4];
#pragma unroll
  for (int rr = 0; rr < 2; ++rr) { const float* xr = tab + (size_t)(rowa + rr) * 2048;
#pragma unroll
    for (int j = 0; j < 4; ++j) { a[rr][j] = *(const f32x4*)(xr + (j * 64 + lane) * 8); b[rr][j] = *(const f32x4*)(xr + (j * 64 + lane) * 8 + 4); } }
#pragma unroll
  for (int rr = 0; rr < 2; ++rr) { const int row = rowa + rr; float bm = 0.f;
#pragma unroll
    for (int j = 0; j < 4; ++j) { bm = fmaxf(bm, fmaxf(fmaxf(fabsf(a[rr][j][0]), fabsf(a[rr][j][1])), fmaxf(fabsf(a[rr][j][2]), fabsf(a[rr][j][3]))));
      bm = fmaxf(bm, fmaxf(fmaxf(fabsf(b[rr][j][0]), fabsf(b[rr][j][1])), fmaxf(fabsf(b[rr][j][2]), fabsf(b[rr][j][3])))); }
    const float mx = wave_max(bm);
    float dq = 1.0f; if (mx > 0.f) dq = __uint_as_float((__float_as_uint(mx * (1.0f / 6.0f)) + 0xffffu) & 0xffff0000u);
    const float s = 1.0f / dq;
    if (lane == 0) sc[row] = dq;
    int k = 100; if (bm > 0.f) { k = (int)((__float_as_uint(6.0f / (bm * s)) >> 23) & 0xffu) - 127; k = k < 0 ? 0 : (k > 100 ? 100 : k); }
    const float up = s * __uint_as_float((unsigned)(127 + k) << 23);
    u32x4 w;
#pragma unroll
    for (int j = 0; j < 4; ++j) { unsigned v = 0u;
      v = __builtin_amdgcn_cvt_scalef32_pk_fp4_f32(v, a[rr][j][0] * up, a[rr][j][1] * up, 1.0f, 0); v = __builtin_amdgcn_cvt_scalef32_pk_fp4_f32(v, a[rr][j][2] * up, a[rr][j][3] * up, 1.0f, 1);
      v = __builtin_amdgcn_cvt_scalef32_pk_fp4_f32(v, b[rr][j][0] * up, b[rr][j][1] * up, 1.0f, 2); v = __builtin_amdgcn_cvt_scalef32_pk_fp4_f32(v, b[rr][j][2] * up, b[rr][j][3] * up, 1.0f, 3); w[j] = v; }
    unsigned char* rp = t4 + (size_t)row * T4_EXP;
    *(u32x4*)(rp + which * T4_V + lane * 16) = w;
    rp[T4_SC + (which ? 64 + lane : 16 * (lane & 3) + (lane >> 2))] = (unsigned char)(127 - k); }
}
template <int q>
__device__ __forceinline__ void sgu_pool_item(int nb, const h16* __restrict__ U, const h16* __restrict__ V, const h16* __restrict__ Z, const f32x2* __restrict__ lnst,
                                              const float* __restrict__ ln_g, const float* __restrict__ ln_b, const h16* __restrict__ Wsgu, const float* __restrict__ sgu_b,
                                              h16* __restrict__ A2, LAS unsigned char* lds) {
  const int tid = threadIdx.x, lane = tid & 63, wid = tid >> 6;
  LAS h16* vt = (LAS h16*)lds;
  LAS f32x2* stat = (LAS f32x2*)(lds + 36864);
  const int t0 = nb * 128;
  __syncthreads();
  if (tid < 128) { const f32x2* p = lnst + (size_t)(t0 + tid) * 16; float s = 0.f, ss = 0.f;
#pragma unroll
    for (int i = 0; i < 16; ++i) { const f32x2 v = p[i]; s += v.x; ss += v.y; }
    const float mean = s * (1.0f / 1024.0f); const float var = fmaxf(ss * (1.0f / 1024.0f) - mean * mean, 0.f);
    stat[tid] = (f32x2){mean, rsqrtf(var + EPS_)}; }
  __syncthreads();
  half8 vreg[4];
#pragma unroll
  for (int i = 0; i < 4; ++i) { const int ch = tid + NTHREADS * i; const int j = ch >> 4, d8 = (ch & 15) * 8; vreg[i] = *(const half8*)(V + (size_t)(t0 + j) * 1024 + (4 * q) * 128 + d8); }
  for (int hh = 0; hh < 4; ++hh) {
    const int h = 4 * q + hh;
#pragma unroll
    for (int i = 0; i < 4; ++i) { const int ch = tid + NTHREADS * i; const int j = ch >> 4, d8 = (ch & 15) * 8;
      const half8 v = vreg[i];
      const f32x2 st = stat[j];
      const f32x4 g0 = *(const f32x4*)(ln_g + h * 128 + d8), g1 = *(const f32x4*)(ln_g + h * 128 + d8 + 4), b0 = *(const f32x4*)(ln_b + h * 128 + d8), b1 = *(const f32x4*)(ln_b + h * 128 + d8 + 4);
#pragma unroll
      for (int e = 0; e < 8; ++e) { const float gg = e < 4 ? g0[e & 3] : g1[e & 3], bb = e < 4 ? b0[e & 3] : b1[e & 3];
        vt[(d8 + e) * 136 + (j ^ (((d8 >> 3) & 15) << 3))] = (h16)(((float)v[e] - st.x) * st.y * gg + bb); } }
    __syncthreads();
    const int i_row = 16 * wid + (lane & 15);
    const size_t tok = (size_t)(t0 + i_row);
    { const int hn = hh < 3 ? h + 1 : h;
#pragma unroll
      for (int i = 0; i < 4; ++i) { const int ch = tid + NTHREADS * i; const int j = ch >> 4, d8 = (ch & 15) * 8; vreg[i] = *(const half8*)(V + (size_t)(t0 + j) * 1024 + hn * 128 + d8); } }
    half4 ureg[8];
#pragma unroll
    for (int nt = 0; nt < 8; ++nt) ureg[nt] = *(const half4*)(U + tok * 1024 + h * 128 + 16 * nt + 4 * (lane >> 4));
    f32x4 acc[8];
#pragma unroll
    for (int nt = 0; nt < 8; ++nt) acc[nt] = (f32x4){0.f, 0.f, 0.f, 0.f};
    const int ksteps = (wid < 4) ? 2 : 4;
    half8 wfr[4];
#pragma unroll
    for (int kk = 0; kk < 4; ++kk) wfr[kk] = *(const half8*)(Wsgu + ((size_t)h * 128 + i_row) * 128 + kk * 32 + 8 * (lane >> 4));
#pragma unroll
    for (int kk = 0; kk < 4; ++kk) { if (kk < ksteps) {
      const half8 wf = wfr[kk];
#pragma unroll
      for (int nt = 0; nt < 8; ++nt) { const int dr_ = 16 * nt + (lane & 15); const half8 vf = *(const LAS half8*)(vt + dr_ * 136 + ((kk * 32 + 8 * (lane >> 4)) ^ (((dr_ >> 3) & 15) << 3)));
        acc[nt] = __builtin_amdgcn_mfma_f32_16x16x32_f16(vf, wf, acc[nt], 0, 0, 0); }
    } }
    const float bias = sgu_b[h * 128 + i_row];
#pragma unroll
    for (int nt = 0; nt < 8; ++nt) { const int d0 = 16 * nt + 4 * (lane >> 4);
      const half4 uu = ureg[nt];
      u32x2 w; w.x = pk_h2((float)uu[0] * (acc[nt][0] + bias), (float)uu[1] * (acc[nt][1] + bias)); w.y = pk_h2((float)uu[2] * (acc[nt][2] + bias), (float)uu[3] * (acc[nt][3] + bias));
      *(u32x2*)(A2 + tok * 2048 + h * 128 + d0) = w; }
    __syncthreads();
  }
  { const int cc = tid & 63, tr = tid >> 6; const int col = 512 * q + cc * 8; const int g = col >> 8, w = 2 << g;
    constexpr int wmax = 2 << (2 * q + 1);
    for (int half = 0; half < 2; ++half) {
      const int tfirst = t0 + (tr * 2 + half) * 8; const int pos0 = tfirst & (SEQ_ - 1);
      half8 zr[23];
#pragma unroll
      for (int i = 0; i < 23; ++i) { const int d = i - 15;
        if (d >= 0 || (-d) < wmax) { const int dd = (pos0 + d >= 0) ? d : -pos0;
          zr[i] = *(const half8*)(Z + (size_t)(tfirst + dd) * 1024 + col); } else { half8 zz = {0, 0, 0, 0, 0, 0, 0, 0}; zr[i] = zz; } }
      float sum[8];
#pragma unroll
      for (int e = 0; e < 8; ++e) sum[e] = 0.f;
#pragma unroll
      for (int s = 1; s < wmax; ++s) { if (s < w && pos0 - s >= 0) {
#pragma unroll
          for (int e = 0; e < 8; ++e) sum[e] += (float)zr[15 - s][e]; } }
#pragma unroll
      for (int i = 0; i < 8; ++i) { const int t = tfirst + i, pos = pos0 + i;
#pragma unroll
        for (int e = 0; e < 8; ++e) sum[e] += (float)zr[15 + i][e];
        const int cnt = pos + 1 < w ? pos + 1 : w; const float inv = 1.0f / (float)cnt;
        u32x4 o; float y[8];
#pragma unroll
        for (int e = 0; e < 8; ++e) y[e] = sum[e] * inv - (float)zr[15 + i][e];
        o.x = pk_h2(y[0], y[1]); o.y = pk_h2(y[2], y[3]); o.z = pk_h2(y[4], y[5]); o.w = pk_h2(y[6], y[7]);
        *(u32x4*)(A2 + (size_t)t * 2048 + 1024 + col) = o;
        if (pos - w + 1 >= 0) {
#pragma unroll
          for (int e = 0; e < 8; ++e) { const float zo = (w == wmax) ? (float)zr[16 + i - wmax][e] : (float)zr[16 + i - wmax / 2][e]; sum[e] -= zo; } } }
    }
  }
}
constexpr int P6_TS = 0, P6_TI = 32768, P6_REC = 0, P6_IG = 40960, P6_GE = 73728, P6_GG = 90112;
__device__ __forceinline__ float gelu_poly(float v) {
  const float av = fabsf(v), t = __builtin_amdgcn_rcpf(av * 0.2316418882f + 1.0f);
  float q = t * 0.5307027145f + (-0.7265760135f); q = q * t + 0.7107068705f; q = q * t + (-0.142248368f); q = q * t + 0.127414796f; q = q * t;
  const float e = __builtin_amdgcn_exp2f((v * v) * (-0.72134752044f));
  const float m = v * (q * e);
  return v < 0.f ? m : v - m;
}
__device__ __forceinline__ unsigned f2key(float x, unsigned tag, unsigned mask) { const unsigned b = __float_as_uint(x); const unsigned k = b ^ ((unsigned)((int)b >> 31) | 0x80000000u); return (k & ~mask) | tag; }
__device__ __forceinline__ float key2f(unsigned k, unsigned mask) { k &= ~mask; const unsigned b = (k & 0x80000000u) ? (k ^ 0x80000000u) : ~k; return __uint_as_float(b); }
#define CE_DESC(A, B) do { const unsigned _hi = (A) > (B) ? (A) : (B), _lo = (A) > (B) ? (B) : (A); (A) = _hi; (B) = _lo; } while (0)
__device__ __forceinline__ void sort16_desc(unsigned (&g)[16]) {
#pragma unroll
  for (int k = 2; k <= 16; k <<= 1)
#pragma unroll
    for (int j = k >> 1; j > 0; j >>= 1)
#pragma unroll
      for (int i = 0; i < 16; ++i) { const int l = i ^ j; if (l > i) { if ((i & k) == 0) CE_DESC(g[i], g[l]); else CE_DESC(g[l], g[i]); } }
}
__device__ __forceinline__ void merge16_desc(unsigned (&r)[16], const unsigned (&g)[16]) {
#pragma unroll
  for (int i = 0; i < 16; ++i) r[i] = r[i] > g[15 - i] ? r[i] : g[15 - i];
#pragma unroll
  for (int j = 8; j > 0; j >>= 1)
#pragma unroll
    for (int i = 0; i < 16; ++i) { const int l = i ^ j; if (l > i) CE_DESC(r[i], r[l]); }
}
__device__ __forceinline__ void peer_topk(const h16* S, const float* SU, const float* SV, int tw0, LAS unsigned char* lds) {
  LAS float* ts = (LAS float*)(lds + P6_TS); LAS unsigned char* ti = lds + P6_TI; LAS int* ig = (LAS int*)(lds + P6_IG); LAS unsigned short* ge = (LAS unsigned short*)(lds + P6_GE); LAS float* gg = (LAS float*)(lds + P6_GG);
  const int tid = threadIdx.x;
  for (int r = 0; r < 2; ++r) {
    { const int tl = tid >> 4, l = tid & 15; const int t = tw0 + 32 * r + tl;
      const h16* sp = S + ((size_t)((t >> 4) * 128 + l * 8)) * 256 + (size_t)((t & 15) * 16);
      unsigned top[16], grp[16];
      half8 cur[2], nxt[2];
#pragma unroll
      for (int c = 0; c < 2; ++c) cur[c] = *(const half8*)(sp + c * 8);
      for (int jj = 0; jj < 8; ++jj) {
        const int jn = jj < 7 ? jj + 1 : 7;
#pragma unroll
        for (int c = 0; c < 2; ++c) nxt[c] = *(const half8*)(sp + jn * 256 + c * 8);
#pragma unroll
        for (int c = 0; c < 2; ++c)
#pragma unroll
          for (int e = 0; e < 8; ++e) grp[c * 8 + e] = f2key((float)cur[c][e], (unsigned)(jj * 16 + c * 8 + e), 127u);
        sort16_desc(grp);
        if (jj == 0) {
#pragma unroll
          for (int i = 0; i < 16; ++i) top[i] = grp[i]; }
        else merge16_desc(top, grp);
#pragma unroll
        for (int c = 0; c < 2; ++c) cur[c] = nxt[c]; }
      __syncthreads();
#pragma unroll
      for (int k = 0; k < 16; ++k) { ts[(tl * 16 + l) * 16 + k] = key2f(top[k], 127u); ti[(tl * 16 + l) * 16 + k] = (unsigned char)(top[k] & 127u); }
    }
    __syncthreads();
    if (tid < 256) { const int tl = tid >> 3, h = tid & 7;
      LAS const float* pa = ts + (tl * 16 + 2 * h) * 16; LAS const float* pb = pa + 16;
      float a[16], b[16];
#pragma unroll
      for (int k = 0; k < 16; ++k) { a[k] = pa[k]; b[k] = pb[k]; }
      unsigned top[16], grp[16]; int ng = 0, filled = 0;
#pragma unroll
      for (int i = 0; i < 16; ++i)
#pragma unroll
        for (int j = 0; j < 16; ++j) if ((i + 1) * (j + 1) <= 16) {
          grp[ng] = f2key(a[i] + b[j], (unsigned)(i * 16 + j), 255u); ++ng;
          if (ng == 16) { sort16_desc(grp); if (!filled) {
#pragma unroll
              for (int q = 0; q < 16; ++q) top[q] = grp[q];
              filled = 1; } else merge16_desc(top, grp); ng = 0; } }
#pragma unroll
      for (int q = 0; q < 16; ++q) if (q >= 2) grp[q] = 0u;
      sort16_desc(grp); merge16_desc(top, grp);
      LAS const unsigned char* ia = ti + (tl * 16 + 2 * h) * 16; LAS const unsigned char* ib = ia + 16;
      float bs[16]; int bid[16];
#pragma unroll
      for (int k = 0; k < 16; ++k) { const unsigned code = top[k] & 255u; const int ci = (int)(code >> 4), cj = (int)(code & 15u); bs[k] = pa[ci] + pb[cj]; bid[k] = (int)ia[ci] * 128 + (int)ib[cj]; }
      float mxv = bs[0];
#pragma unroll
      for (int k = 1; k < 16; ++k) mxv = fmaxf(mxv, bs[k]);
      float ex[16]; float sum = 0.f;
#pragma unroll
      for (int k = 0; k < 16; ++k) { ex[k] = __expf(bs[k] - mxv); sum += ex[k]; }
      const float inv = 1.0f / sum;
#pragma unroll
      for (int k = 0; k < 16; ++k) { const int id = bid[k]; const int o = (32 * r + tl) * 128 + h * 16 + k;
        ig[o] = id; ge[o] = (unsigned short)(__float_as_uint(SU[id]) >> 16); gg[o] = ex[k] * inv * SV[id]; }
    }
  }
  __syncthreads();
  { const int lane = tid & 63, wv = tid >> 6;
    unsigned rw[4][4]; float rg[4][4];
#pragma unroll
    for (int r = 0; r < 4; ++r) { const int tlA = 8 * wv + 2 * r;
      unsigned key[4];
#pragma unroll
      for (int q = 0; q < 4; ++q) { const int tok = q >> 1, slot = (q & 1) * 64 + lane; key[q] = ((unsigned)ig[(tlA + tok) * 128 + slot] << 8) | (unsigned)(tok << 7) | (unsigned)slot; }
#pragma unroll
      for (int k = 2; k <= 128; k <<= 1) {
#pragma unroll
        for (int j = k >> 1; j > 0; j >>= 1) {
          if (j >= 64) { const int rj = j >> 6;
#pragma unroll
            for (int q = 0; q < 4; ++q) if ((q & rj) == 0) { const int q2 = q | rj; const bool asc = true;
              const unsigned lo = key[q] < key[q2] ? key[q] : key[q2], hi = key[q] < key[q2] ? key[q2] : key[q];
              key[q] = asc ? lo : hi; key[q2] = asc ? hi : lo; } }
          else { const bool lower = (lane & j) == 0;
#pragma unroll
            for (int q = 0; q < 4; ++q) { const unsigned pp = (unsigned)__shfl_xor((int)key[q], j);
              const bool asc = (k >= 128) ? true : ((k == 64) ? ((q & 1) == 0) : ((lane & k) == 0));
              const unsigned mn = key[q] < pp ? key[q] : pp, mx = key[q] < pp ? pp : key[q];
              key[q] = (lower == asc) ? mn : mx; } } } }
#pragma unroll
      for (int q = 0; q < 4; ++q) { const unsigned tok = (key[q] >> 7) & 1u, slot = key[q] & 127u; const int o = (tlA + (int)tok) * 128 + (int)slot; const unsigned ee = ge[o];
        rw[r][q] = (key[q] >> 8) | (tok << 14) | (ee << 16); rg[r][q] = gg[o]; } }
    __syncthreads();
    LAS u32x2* rec = (LAS u32x2*)(lds + P6_REC) + wv * 1024;
#pragma unroll
    for (int r = 0; r < 4; ++r)
#pragma unroll
      for (int q = 0; q < 4; ++q) rec[r * 256 + q * 64 + lane] = (u32x2){rw[r][q], __float_as_uint(rg[r][q])};
  }
  __syncthreads();
}

constexpr int P6_XQ = 65536, P6_ZERO = P6_XQ + 8 * 4096;
typedef int i32x8 __attribute__((ext_vector_type(8)));
__device__ __forceinline__ void peer_gather_wave(const h16* h2, float* out, const unsigned char* U6, const float* __restrict__ g_peer, const float* __restrict__ g_final,
                                                 int t0, LAS unsigned char* lds) {
  const int lane = threadIdx.x & 63, wv = __builtin_amdgcn_readfirstlane(threadIdx.x >> 6);
  t0 = __builtin_amdgcn_readfirstlane(t0);
  LAS const u32x2* recw = (LAS const u32x2*)(lds + P6_REC) + wv * 1024;
  const unsigned loff = (unsigned)lane * 16u;
  const int mrow = lane & 15, kb = lane >> 4;
  if (lane < 16) ((LAS unsigned*)(lds + P6_ZERO))[lane] = 0u;
  const unsigned xb = mrow < 2 ? (unsigned)(P6_XQ + wv * 4096 + mrow * 2048 + kb * 32) : (unsigned)P6_ZERO, xs = mrow < 2 ? 128u : 0u;
  const unsigned ridx = (unsigned)((mrow < 8 ? 0 : 128) + (mrow & 7));
  struct UT { u32x4 a[16]; u32x4 sc; };
  struct VB { u32x4 v; unsigned sc; };
#define CV4(W, SC, SEL) __builtin_bit_cast(half2v, __builtin_amdgcn_cvt_scalef32_pk_f16_fp4((W), (SC), (SEL)))
#define A_FMA(AC, C, A2) asm("v_pk_fma_f16 %0, %1, %2, %0 op_sel_hi:[1,0,1]" : "+v"(AC) : "v"(C), "v"(A2))
#define G_FMA(B, AC, AF) do { const float sv = __uint_as_float(B.sc << 23); const unsigned a2 = pk_h2((AF), 0.f); \
      _Pragma("unroll") for (int q_ = 0; q_ < 4; ++q_) { \
        A_FMA(AC[4 * q_], CV4(B.v[q_], sv, 0), a2); A_FMA(AC[4 * q_ + 1], CV4(B.v[q_], sv, 1), a2); A_FMA(AC[4 * q_ + 2], CV4(B.v[q_], sv, 2), a2); A_FMA(AC[4 * q_ + 3], CV4(B.v[q_], sv, 3), a2); } } while (0)
#define U_LOAD(T, W0) do { const unsigned char* _ap = U6 + ((size_t)(((W0) & 16383u) * T4_EXP) + (size_t)(kb * 16)); \
      _Pragma("unroll") for (int s_ = 0; s_ < 16; ++s_) T.a[s_] = *(const u32x4*)(_ap + 64 * s_); T.sc = *(const u32x4*)(_ap + T4_SC); } while (0)
#define V_LOAD(B, W0S) do { const unsigned char* _vp = U6 + (size_t)(((W0S) & 16383u) * T4_EXP); B.v = *(const u32x4*)(_vp + (loff + T4_V)); B.sc = *(const unsigned char*)(_vp + ((unsigned)lane + (T4_SC + 64u))); } while (0)
  for (int r = 0; r < 4; ++r) {
    asm volatile("" ::: "memory");
    unsigned aA[16], aB[16];
#define MK_NQ(TOK, SLOT) do { unsigned ln_ = loff; asm volatile("" : "+v"(ln_)); const unsigned l32 = ln_ * 2u; const unsigned char* hb = (const unsigned char*)h2 + (size_t)((TOK) >> 4) * 65536 + (size_t)((TOK) & 15) * 64; const unsigned hoff = (ln_ >> 6) * 1024u + ((ln_ >> 4) & 3u) * 16u; const unsigned char* gb_ = (const unsigned char*)g_peer; half8 x[4]; float ss = 0.f; \
      _Pragma("unroll") for (int c = 0; c < 4; ++c) { x[c] = *(const half8*)(hb + (hoff + (unsigned)(c * 16384))); \
        _Pragma("unroll") for (int e = 0; e < 8; ++e) { const float xf = (float)x[c][e]; ss += xf * xf; } } \
      ss = wave_sum(ss); const float r3 = rsqrtf(ss * (1.0f / 2048.0f) + EPS_); unsigned qw[8]; \
      _Pragma("unroll") for (int c = 0; c < 4; ++c) { const f32x4 ga = *(const f32x4*)(gb_ + (l32 + (unsigned)(c * 2048))), gb = *(const f32x4*)(gb_ + (l32 + (unsigned)(c * 2048 + 16))); \
        int w0_ = __builtin_amdgcn_cvt_pk_fp8_f32((float)x[c][0] * r3 * ga[0], (float)x[c][1] * r3 * ga[1], 0, false); w0_ = __builtin_amdgcn_cvt_pk_fp8_f32((float)x[c][2] * r3 * ga[2], (float)x[c][3] * r3 * ga[3], w0_, true); \
        int w1_ = __builtin_amdgcn_cvt_pk_fp8_f32((float)x[c][4] * r3 * gb[0], (float)x[c][5] * r3 * gb[1], 0, false); w1_ = __builtin_amdgcn_cvt_pk_fp8_f32((float)x[c][6] * r3 * gb[2], (float)x[c][7] * r3 * gb[3], w1_, true); \
        qw[2 * c] = (unsigned)w0_; qw[2 * c + 1] = (unsigned)w1_; } \
        \
      const unsigned lb_ = ln_ >> 4; LAS unsigned char* xd = lds + (P6_XQ + wv * 4096 + (SLOT) * 2048) + (((lb_ & ~3u) + 2u * (lb_ & 1u)) * 32u + 16u * ((lb_ >> 1) & 1u)); \
      *(LAS u32x4*)xd = (u32x4){qw[0], qw[1], qw[2], qw[3]}; *(LAS u32x4*)(xd + 32) = (u32x4){qw[4], qw[5], qw[6], qw[7]}; } while (0)
    const int tA = t0 + 2 * r, tB = tA + 1;
    MK_NQ(tA, 0); MK_NQ(tB, 1);
#undef MK_NQ
#pragma unroll
    for (int i = 0; i < 16; ++i) { aA[i] = 0u; aB[i] = 0u; }
    LAS const u32x2* recr = recw + r * 256;
    UT ut; VB vb[8];
    unsigned w0c = recr[ridx].x;
    U_LOAD(ut, w0c);
#pragma unroll
    for (int m2 = 0; m2 < 8; ++m2) { const unsigned ws_ = (unsigned)__builtin_amdgcn_readlane((int)w0c, m2); V_LOAD(vb[m2], ws_); }
    for (int q = 0; q < 16; ++q) {
      const int qn = q < 15 ? q + 1 : 15;
      const unsigned w0n = recr[ridx + 8 * qn].x;
      f32x4 D = (f32x4){0.f, 0.f, 0.f, 0.f};
      unsigned xbq = xb; asm volatile("" : "+v"(xbq));
#define M_STEP(S) do { const u32x4 b0 = *(LAS const u32x4*)(lds + (xbq + xs * (unsigned)(S))), b1 = *(LAS const u32x4*)(lds + (xbq + xs * (unsigned)(S) + 16u)); \
        const i32x8 Af = {(int)ut.a[S].x, (int)ut.a[S].y, (int)ut.a[S].z, (int)ut.a[S].w, 0, 0, 0, 0}; \
        const i32x8 Bf = {(int)b0.x, (int)b0.y, (int)b0.z, (int)b0.w, (int)b1.x, (int)b1.y, (int)b1.z, (int)b1.w}; \
        D = __builtin_amdgcn_mfma_scale_f32_16x16x128_f8f6f4(Af, Bf, D, 4, 0, (S) & 3, (int)ut.sc[(S) >> 2], 0, 0x7f7f7f7f); } while (0)
      M_STEP(0); M_STEP(1); M_STEP(2); M_STEP(3); M_STEP(4); M_STEP(5); M_STEP(6); M_STEP(7); M_STEP(8); M_STEP(9); M_STEP(10); M_STEP(11); M_STEP(12); M_STEP(13); M_STEP(14); M_STEP(15);
#undef M_STEP
      { unsigned w0u = w0n; float d0_ = D[0]; asm volatile("" : "+v"(w0u), "+v"(d0_)); D[0] = d0_; U_LOAD(ut, w0u); }
      float cf[4];
#pragma unroll
      for (int i = 0; i < 4; ++i) { const int row = 4 * kb + i; const u32x2 rr = recr[(row < 8 ? 0 : 128) + 8 * q + (row & 7)]; cf[i] = gelu_poly(D[i] * __uint_as_float(rr.x & 0xffff0000u)) * __uint_as_float(rr.y); }
#pragma unroll
      for (int m2 = 0; m2 < 16; ++m2) {
        const float co = __builtin_bit_cast(float, __builtin_amdgcn_readlane(__builtin_bit_cast(int, cf[m2 & 3]), 16 * (m2 >> 2) + (m2 >> 3)));
        if (m2 < 8) G_FMA(vb[m2 & 7], aA, co); else G_FMA(vb[m2 & 7], aB, co);
        const unsigned ws_ = (unsigned)__builtin_amdgcn_readlane((int)(m2 < 8 ? w0c : w0n), (m2 + 8) & 15); V_LOAD(vb[m2 & 7], ws_); }
      w0c = w0n;
    }
    asm volatile("" ::: "memory");
#define G_OUT(AC, TOK) do { unsigned ln_ = loff; asm volatile("" : "+v"(ln_)); const unsigned l32 = ln_ * 2u, l64 = ln_ * 4u; const unsigned char* hb = (const unsigned char*)h2 + (size_t)((TOK) >> 4) * 65536 + (size_t)((TOK) & 15) * 64; const unsigned hoff = (ln_ >> 6) * 1024u + ((ln_ >> 4) & 3u) * 16u; unsigned char* ob = (unsigned char*)out + (size_t)(TOK) * 8192; const unsigned char* gf_ = (const unsigned char*)g_final; float hv[32]; float s2 = 0.f; \
      _Pragma("unroll") for (int c = 0; c < 4; ++c) { const half8 x = *(const half8*)(hb + (hoff + (unsigned)(c * 16384))); \
        _Pragma("unroll") for (int e2 = 0; e2 < 4; ++e2) { const half2v av = __builtin_bit_cast(half2v, AC[c * 4 + e2]); \
          const float h0 = (float)x[e2 * 2] + (float)av.x, h1 = (float)x[e2 * 2 + 1] + (float)av.y; hv[c * 8 + e2 * 2] = h0; hv[c * 8 + e2 * 2 + 1] = h1; s2 += h0 * h0 + h1 * h1; } } \
      s2 = wave_sum(s2); const float rf = rsqrtf(s2 * (1.0f / 2048.0f) + EPS_); \
      _Pragma("unroll") for (int j = 0; j < 4; ++j) _Pragma("unroll") for (int q = 0; q < 2; ++q) { const f32x4 g = *(const f32x4*)(gf_ + (l32 + (unsigned)(j * 2048 + q * 16))); f32x4 o; \
          _Pragma("unroll") for (int e = 0; e < 4; ++e) o[e] = hv[j * 8 + q * 4 + e] * rf * g[e]; \
          *(f32x4*)(ob + (l32 + (unsigned)(j * 2048 + q * 16))) = o; } } while (0)
    G_OUT(aA, tA); asm volatile("" ::: "memory"); G_OUT(aB, tB);
#undef G_OUT
  }
#undef CV4
#undef A_FMA
#undef G_FMA
#undef U_LOAD
#undef V_LOAD
}
struct Args { const float* in[22]; float* out; unsigned char* ws; int ph_lo, ph_hi; };

__device__ __forceinline__ void p0a_chunk(int id, const Args& a, LAS unsigned char* lds) {
  unsigned char* ws = a.ws;
  const float* mem = a.in[1]; const float* g_mix = a.in[2]; const float* w_in = a.in[3]; const float* pool_w = a.in[8]; const float* g_mem = a.in[12]; const float* w_kv = a.in[14];
  const float* g_peer = a.in[16]; const float* w_query = a.in[17]; const float* sub_keys = a.in[18];
  if (id < 1024) { conv_trans_tile(w_kv, 4096, (id >> 5) * 64, (id & 31) * 128, (h16*)(ws + O_WKVT), 2048, nullptr, 0, lds); return; }
  id -= 1024;
  if (id < 32) { conv_rows_norm(mem, id * 16, (h16*)(ws + O_M16), nullptr, g_mem); return; }
  id -= 32;
  if (id < 128) { conv_copy_rows(w_in + 2048, 3072, id * 16, 16, 1024, (h16*)(ws + O_WINZ), 1024, g_mix); return; }
  id -= 128;
  if (id < 32) { const int g = id >> 3, t = id & 7; conv_trans_tile(pool_w + (size_t)g * 65536, 256, (t >> 1) * 64, (t & 1) * 128, (h16*)(ws + O_WPOOLT) + (size_t)g * 65536, 256, nullptr, 0, lds); return; }
  id -= 32;
  if (id < 256) { conv_copy_rows(w_query, 2048, id * 8, 8, 2048, (h16*)(ws + O_WQRY), 2048, g_peer); return; }
  id -= 256;
  { h16* dst = (h16*)(ws + O_SKBD);
    for (int i = threadIdx.x; i < 2048; i += NTHREADS) { const int e0 = id * 16384 + i * 8; const int h = e0 >> 16, r = (e0 >> 8) & 255, c = e0 & 255; const int p = r >> 7, key = r & 127, pp = c >> 7, cc = c & 127;
      u32x4 w = (u32x4){0u, 0u, 0u, 0u};
      if (p == pp) { const float* s = sub_keys + ((size_t)((h * 2 + p) * 128 + key)) * 128 + cc; const f32x4 x = *(const f32x4*)s, y = *(const f32x4*)(s + 4);
        w.x = pk_h2(x[0], x[1]); w.y = pk_h2(x[2], x[3]); w.z = pk_h2(y[0], y[1]); w.w = pk_h2(y[2], y[3]); }
      *(u32x4*)(dst + e0) = w; } }
}
constexpr int P0A_CHUNKS = 1024 + 32 + 128 + 32 + 256 + 32;

__device__ __forceinline__ void p0b_chunk(int id, const Args& a, LAS unsigned char* lds) {
  unsigned char* ws = a.ws;
  const float* x = a.in[0]; const float* g_mix = a.in[2]; const float* w_in = a.in[3]; const float* sgu_w = a.in[6]; const float* pool_scale = a.in[9]; const float* w_out = a.in[10];
  const float* g_xattn = a.in[11]; const float* w_q = a.in[13]; const float* w_o = a.in[15]; const float* peer_u = a.in[19]; const float* peer_v = a.in[20];
  if (id < 1024) { conv_rows_norm(x, id * 16, (h16*)(ws + O_X16), (float*)(ws + O_RSTD1), nullptr); return; }
  id -= 1024;
  if (id < 512) { conv_trans_tile(w_in, 3072, (id >> 4) * 64, (id & 15) * 128, (h16*)(ws + O_W1T), 2048, g_mix, 0, lds); return; }
  id -= 512;
  if (id < 512) { conv_trans_tile(w_out, 2048, (id >> 4) * 64, (id & 15) * 128, (h16*)(ws + O_W3T), 2048, pool_scale, -1024, lds); return; }
  id -= 512;
  if (id < 512) { conv_trans_tile(w_o, 2048, (id >> 4) * 64, (id & 15) * 128, (h16*)(ws + O_WOT), 2048, nullptr, 0, lds); return; }
  id -= 512;
  if (id < 256) { conv_copy_rows(w_q, 2048, id * 8, 8, 2048, (h16*)(ws + O_WQ16), 2048, g_xattn); return; }
  id -= 256;
  if (id < 8) { h16* dst = (h16*)(ws + O_WSGU);
    for (int i = threadIdx.x; i < 2048; i += NTHREADS) { const int e0 = id * 16384 + i * 8; const int ii = (e0 >> 7) & 127, j = e0 & 127;
      u32x4 w = (u32x4){0u, 0u, 0u, 0u};
      if ((j >> 6) <= (ii >> 6)) { const f32x4 p = *(const f32x4*)(sgu_w + e0), q = *(const f32x4*)(sgu_w + e0 + 4); w.x = pk_h2(p[0], p[1]); w.y = pk_h2(p[2], p[3]); w.z = pk_h2(q[0], q[1]); w.w = pk_h2(q[2], q[3]); }
      *(u32x4*)(dst + e0) = w; }
    return; }
  id -= 8;
  if (id < 1024) { conv_table_rows(peer_u, id * 16, ws + O_U8, (float*)(ws + O_SU), 0); return; }
  id -= 1024;
  conv_table_rows(peer_v, id * 16, ws + O_U8, (float*)(ws + O_SV), 1);
}
constexpr int P0B_CHUNKS = 1024 + 512 * 3 + 256 + 8 + 2048;

#define XB_TMO      128
#define XB_XCNT(j)  (256  + 64 * (j))
#define XB_XSUB(j)  (1280 + 64 * (j))
#define XB_XGEN(j)  (2304 + 64 * (j))
#define XB_TOP      3328
#define XB_TOPGEN   3392
#define XCD_BAR_WORDS 3456
#define XB_SPIN_CAP (1u << 20)
__device__ __forceinline__ unsigned xb_ld(unsigned* p)              { return __hip_atomic_load(p, __ATOMIC_RELAXED, __HIP_MEMORY_SCOPE_AGENT); }
__device__ __forceinline__ unsigned xb_add(unsigned* p, unsigned v) { return __hip_atomic_fetch_add(p, v, __ATOMIC_RELAXED, __HIP_MEMORY_SCOPE_AGENT); }
__device__ __forceinline__ unsigned xb_xcc_id() { return (unsigned)__builtin_amdgcn_s_getreg((3 << 11) | 20) & 0xFu; }
#define XB_SPIN(cond, bar) do { unsigned _sp = 0; while (cond) { __builtin_amdgcn_s_sleep(1); \
    if ((++_sp & 255u) == 0u) { if (xb_ld(&(bar)[XB_TMO])) break; if (_sp > XB_SPIN_CAP) { atomicAdd(&(bar)[XB_TMO], 1u); break; } } } } while (0)
struct XcdBarrier { unsigned* bar; unsigned x; volatile LAS unsigned* st; };
__device__ __forceinline__ XcdBarrier xcd_barrier_post(unsigned* bar, volatile LAS unsigned* st) {
  XcdBarrier b; b.bar = bar; b.x = xb_xcc_id(); b.st = st;
  if (threadIdx.x == 0) (void)xb_add(&bar[XB_XCNT(b.x)], 1u);
  return b;
}
__device__ __forceinline__ void xcd_barrier_complete(unsigned* bar, unsigned x, unsigned& nloc, unsigned& nx) {
  const unsigned G = gridDim.x; unsigned sum, cnt, mine, sp = 0u;
  for (;;) { sum = 0u; cnt = 0u; mine = 0u;
#pragma unroll
    for (unsigned j = 0; j < 16; ++j) { const unsigned c = xb_ld(&bar[XB_XCNT(j)]); sum += c; cnt += (c > 0u) ? 1u : 0u; mine = (j == x) ? c : mine; }
    if (sum == G) break;
    __builtin_amdgcn_s_sleep(1);
    if ((++sp & 255u) == 0u) { if (xb_ld(&bar[XB_TMO])) break; if (sp > XB_SPIN_CAP) { atomicAdd(&bar[XB_TMO], 1u); break; } } }
  nloc = mine > 0u ? mine : 1u; nx = cnt > 0u ? cnt : 1u;
}
__device__ __forceinline__ void xcd_barrier(const XcdBarrier& b) {
  asm volatile("s_waitcnt vmcnt(0)" ::: "memory");
  __syncthreads();
  if (threadIdx.x == 0) {
    unsigned* bar = b.bar;
    __builtin_amdgcn_s_waitcnt(0);
    unsigned nloc = b.st[0], nx = b.st[1];
    if (nloc == 0u) { xcd_barrier_complete(bar, b.x, nloc, nx); b.st[0] = nloc; b.st[1] = nx; }
    const unsigned old = xb_add(&bar[XB_XSUB(b.x)], 1u);
    const unsigned gen = old / nloc;
    if (old + 1u == (gen + 1u) * nloc) {
      __builtin_amdgcn_fence(__ATOMIC_RELEASE, "agent");
      asm volatile("s_waitcnt vmcnt(0)" ::: "memory");
      const unsigned og = xb_add(&bar[XB_TOP], 1u);
      const unsigned tg = og / nx;
      if (og + 1u == (tg + 1u) * nx) xb_add(&bar[XB_TOPGEN], 1u);
      else XB_SPIN(xb_ld(&bar[XB_TOPGEN]) == tg, bar);
      __builtin_amdgcn_fence(__ATOMIC_ACQUIRE, "agent");
      xb_add(&bar[XB_XGEN(b.x)], 1u);
      asm volatile("s_waitcnt vmcnt(0)" ::: "memory");
    } else {
      XB_SPIN(xb_ld(&bar[XB_XGEN(b.x)]) == gen, bar);
      __builtin_amdgcn_fence(__ATOMIC_ACQUIRE, "agent");
      asm volatile("s_waitcnt vmcnt(0)" ::: "memory");
    }
  }
  __syncthreads();
}

constexpr int NPHASE = 9;
constexpr int CW_QUEUE = 0;
constexpr int CW_BAR = 1024;

__global__ void __launch_bounds__(NTHREADS, 2) fwd_kernel(Args a) {
  extern __shared__ __attribute__((aligned(16))) unsigned char lds_raw[];
  LAS unsigned char* lds = (LAS unsigned char*)lds_raw;
  const int tid = threadIdx.x, c = blockIdx.x, G = gridDim.x;
  unsigned char* ws = a.ws; unsigned* ctl = (unsigned*)(ws + O_CTL);
  volatile LAS unsigned* misc = (volatile LAS unsigned*)(lds + LDS_BYTES - 64);
  if (tid < 16) misc[tid] = 0u;
  __syncthreads();
  const bool multi = (a.ph_hi - a.ph_lo) > 1;
  XcdBarrier bar; bar.bar = ctl + CW_BAR; bar.x = 0; bar.st = misc + 8;
  if (multi) bar = xcd_barrier_post(ctl + CW_BAR, misc + 8);
#define IN(k) (a.ph_lo <= (k) && (k) < a.ph_hi)
#define SEAM(k) do { if (IN(k) && IN((k) + 1)) xcd_barrier(bar); } while (0)
  const long NOB = 1L << 30;
  if (IN(0)) { for (int id = c; id < P0A_CHUNKS; id += G) p0a_chunk(id, a, lds); }
  SEAM(0);
  if (IN(1)) {
    if (c < 32) { pg::Gemm g{(const h16*)(ws + O_M16), (const h16*)(ws + O_WKVT), 2048, 2048, 2048, (int)NOB, 0, 0}; pg::OneUnit S{{c >> 4, c & 15}}; pg::EpiHalf E{(h16*)(ws + O_KV16), 4096};
      pg::gemm_phase(lds, g, S, E); }
    else if (c < 64) { const int z = (c - 32) >> 3, pn = (c - 32) & 7;
      pg::Gemm g{(const h16*)(ws + O_WPOOLT) + (size_t)z * 65536, (const h16*)(ws + O_WINZ) + z * 256, 256, 1024, 256, (int)NOB, 0, 0}; pg::OneUnit S{{0, pn}};
      pg::EpiHalf E{(h16*)(ws + O_W1T) + (size_t)(2048 + z * 256) * 2048, 2048}; pg::gemm_phase(lds, g, S, E); }
    else if (c < 128) { const int z = (c - 64) >> 3, pn = (c - 64) & 7;
      pg::Gemm g{(const h16*)(ws + O_SKBD) + (size_t)z * 65536, (const h16*)(ws + O_WQRY) + z * 256, 256, 2048, 256, (int)NOB, 0, 0}; pg::OneUnit S{{0, pn}};
      pg::EpiHalf E{(h16*)(ws + O_WQST) + (size_t)z * 256 * 2048, 2048}; pg::gemm_phase(lds, g, S, E); }
    for (;;) { __syncthreads(); if (tid == 0) misc[0] = atomicAdd(ctl + CW_QUEUE, 1u); __syncthreads(); const int id = (int)misc[0]; if (id >= P0B_CHUNKS) break; p0b_chunk(id, a, lds); }
  }
  SEAM(1);
  if (IN(2)) { pg::Gemm g{(const h16*)(ws + O_X16), (const h16*)(ws + O_W1T), 2048, 2048, 2048, (int)NOB, 0, 0}; pg::StaticOrder S; S.init(64, 12, G, c);
    pg::Epi1 E{(const float*)(ws + O_RSTD1), (h16*)(ws + O_RB), (f32x2*)(ws + O_LNST)};
    pg::gemm_phase(lds, g, S, E); }
  SEAM(2);
  if (IN(3)) {
    if (c < 64) { const int z = c >> 3, pn = c & 7, b = z >> 2, h = z & 3;
      pg::Gemm g{(const h16*)(ws + O_KV16) + (size_t)(b * 256) * 4096 + h * 512, (const h16*)(ws + O_WQ16) + h * 512, 4096, 2048, 512, (int)NOB, 0, 0}; pg::OneUnit S{{0, pn}};
      pg::EpiHalf E{(h16*)(ws + O_WQKT) + (size_t)(b * 1024 + h * 256) * 2048, 2048}; pg::gemm_phase(lds, g, S, E); }
    else if (c < 128) { const int z = (c - 64) >> 3, pm = (c - 64) & 7, b = z >> 2, h = z & 3;
      pg::Gemm g{(const h16*)(ws + O_WOT) + h * 512, (const h16*)(ws + O_KV16) + (size_t)(b * 256) * 4096 + 2048 + h * 512, 2048, 4096, 512, (int)NOB, 0, 0}; pg::OneUnit S{{pm, 0}};
      pg::EpiHalf E{(h16*)(ws + O_WVOT) + (size_t)b * 2048 * 1024 + h * 256, 1024}; pg::gemm_phase(lds, g, S, E); }
    for (int it = c; it < 256; it += G) {
      if (it & 1) sgu_pool_item<1>(it >> 1, (const h16*)(ws + O_RB), (const h16*)(ws + O_RB + 32 * MiB), (const h16*)(ws + O_RB + 64 * MiB), (const f32x2*)(ws + O_LNST), a.in[4], a.in[5],
                    (const h16*)(ws + O_WSGU), a.in[7], (h16*)(ws + O_RA), lds);
      else        sgu_pool_item<0>(it >> 1, (const h16*)(ws + O_RB), (const h16*)(ws + O_RB + 32 * MiB), (const h16*)(ws + O_RB + 64 * MiB), (const f32x2*)(ws + O_LNST), a.in[4], a.in[5],
                    (const h16*)(ws + O_WSGU), a.in[7], (h16*)(ws + O_RA), lds); }
  }
  SEAM(3);
  if (IN(4)) { pg::Gemm g{(const h16*)(ws + O_RA), (const h16*)(ws + O_W3T), 2048, 2048, 2048, (int)NOB, 0, 0}; pg::StaticOrder S; S.init(64, 8, G, c);
    pg::EpiRes<false> E{(const h16*)(ws + O_X16), (h16*)(ws + O_RB), (float*)(ws + O_SSQ2)}; pg::gemm_phase(lds, g, S, E); }
  SEAM(4);
  if (IN(5)) { pg::Gemm g{(const h16*)(ws + O_RB), (const h16*)(ws + O_WQKT), 2048, 2048, 2048, 32, (long)1024 * 2048, 1}; pg::StaticOrder S; S.init(64, 4, G, c);
    pg::EpiSoftmax E{(const float*)(ws + O_SSQ2), (h16*)(ws + O_RB + 64 * MiB)}; pg::gemm_phase<pg::EpiSoftmax, pg::StaticOrder, false, true>(lds, g, S, E); }
  SEAM(5);
  if (IN(6)) { pg::Gemm g{(const h16*)(ws + O_RB + 64 * MiB), (const h16*)(ws + O_WVOT), 1024, 1024, 1024, 32, (long)2048 * 1024, 1}; pg::StaticOrder S; S.init(64, 8, G, c);
    pg::EpiRes<true> E{(const h16*)(ws + O_RB), (h16*)(ws + O_RA), (float*)(ws + O_SSQ3)}; pg::gemm_phase(lds, g, S, E); }
  SEAM(6);
  if (IN(7)) { pg::Gemm g{(const h16*)(ws + O_RA), (const h16*)(ws + O_WQST), 2048, 2048, 2048, (int)NOB, 0, 1}; pg::StaticOrder S; S.init(64, 8, G, c);
    pg::EpiScore E{(const float*)(ws + O_SSQ3), (h16*)(ws + O_RB)}; pg::gemm_phase(lds, g, S, E); }
  SEAM(7);
  if (IN(8)) {
    peer_topk((const h16*)(ws + O_RB), (const float*)(ws + O_SU), (const float*)(ws + O_SV), 64 * c, lds);
    const int wid = tid >> 6;
    peer_gather_wave((const h16*)(ws + O_RA), a.out, ws + O_U8, a.in[16], a.in[21], 64 * c + 8 * wid, lds);
  }
#undef IN
#undef SEAM
}
#ifndef HYBRID_CUT
#define HYBRID_CUT 9
#endif
#ifndef ONE_LAUNCH
#define ONE_LAUNCH 0
#endif

#if HYBRID_CUT < 9
static void slow_xattn(hipStream_t stream, void* const* d_in, float* h, float* ws) {
  const float* mem = (const float*)d_in[1]; const float* g_xattn = (const float*)d_in[11]; const float* g_mem = (const float*)d_in[12]; const float* w_q = (const float*)d_in[13]; const float* w_kv = (const float*)d_in[14]; const float* w_o = (const float*)d_in[15];
  float* R0 = ws; float* R1 = R0 + (size_t)TT * 3072; float* S0 = R1 + (size_t)TT * 2048; float* mnorm = S0; float* kv = S0 + (size_t)512 * 2048;
  hipLaunchKernelGGL(k_rmsnorm, dim3(TT), dim3(256), 0, stream, (const float*)h, g_xattn, R1);
  hipLaunchKernelGGL(k_rmsnorm, dim3(512), dim3(256), 0, stream, mem, g_mem, mnorm);
  gemm(stream, mnorm, 2048, w_kv, 4096, 0, kv, 4096, nullptr, 512, 4096, 2048);
  float* q = R0; float* sc = R0 + (size_t)TT * 2048;
  gemm(stream, R1, 2048, w_q, 2048, 0, q, 2048, nullptr, TT, 2048, 2048);
  gemm(stream, q, 2048, kv, 4096, 1, sc, 256, nullptr, SEQ, 256, 512, 8, 4, (long)SEQ * 2048, 512, (long)256 * 4096, 512, (long)4 * SEQ * 256, (long)SEQ * 256);
  hipLaunchKernelGGL(k_softmax256, dim3(8 * SEQ / 4), dim3(256), 0, stream, sc, 0.044194173824159216f);
  gemm(stream, sc, 256, kv + 2048, 4096, 0, R1, 2048, nullptr, SEQ, 512, 256, 8, 4, (long)4 * SEQ * 256, (long)SEQ * 256, (long)256 * 4096, 512, (long)SEQ * 2048, 512);
  gemm(stream, R1, 2048, w_o, 2048, 0, h, 2048, h, TT, 2048, 2048);
}
static void slow_peer(hipStream_t stream, void* const* d_in, float* h, float* ws, float* out) {
  const float* g_peer = (const float*)d_in[16]; const float* w_query = (const float*)d_in[17]; const float* sub_keys = (const float*)d_in[18]; const float* peer_u = (const float*)d_in[19]; const float* peer_v = (const float*)d_in[20]; const float* g_final = (const float*)d_in[21];
  float* R0 = ws; float* R1 = R0 + (size_t)TT * 3072; float* S0 = R1 + (size_t)TT * 2048;
  int* idx = (int*)(S0 + (size_t)TT * 1024); float* gates = S0 + (size_t)TT * 1024 + (size_t)TT * 128;
  hipLaunchKernelGGL(k_rmsnorm, dim3(TT), dim3(256), 0, stream, (const float*)h, g_peer, R1);
  float* pq = R0; float* pscore = R1;
  gemm(stream, R1, 2048, w_query, 2048, 0, pq, 2048, nullptr, TT, 2048, 2048);
  gemm(stream, pq, 2048, sub_keys, 128, 1, pscore, 2048, nullptr, TT, 128, 128, 16, 1, 128, 0, 16384, 0, 128, 0);
  hipLaunchKernelGGL(k_topk, dim3(TT * 8 / 4), dim3(256), 0, stream, (const float*)pscore, idx, gates);
  hipLaunchKernelGGL(k_experts, dim3(TT / 4), dim3(256), 0, stream, g_peer, (const float*)h, (const int*)idx, (const float*)gates, peer_u, peer_v, g_final, out);
}
#endif

extern "C" void kernel_launch(void* const* d_in, const int* in_sizes, int n_in, void* d_out, int out_size, void* d_ws, size_t ws_size, hipStream_t stream) {
  static int grid = 0;
  if (grid == 0) {
    if (n_in != 22 || out_size != T_ * D_ || ws_size < WS_END) { fprintf(stderr, "kernel_launch: unexpected problem shape (n_in %d out %d ws %zu need %zu)\n", n_in, out_size, ws_size, (size_t)WS_END); grid = -1; return; }
    int dev = 0, cus = 0, per_cu = 0;
    (void)hipGetDevice(&dev); (void)hipDeviceGetAttribute(&cus, hipDeviceAttributeMultiprocessorCount, dev);
    if (hipFuncSetAttribute((const void*)fwd_kernel, hipFuncAttributeMaxDynamicSharedMemorySize, LDS_BYTES) != hipSuccess) { fprintf(stderr, "kernel_launch: hipFuncSetAttribute failed\n"); grid = -1; return; }
    (void)hipOccupancyMaxActiveBlocksPerMultiprocessor(&per_cu, (const void*)fwd_kernel, NTHREADS, LDS_BYTES);
    (void)hipGetLastError();
    if (cus != 256 || per_cu < 1) { fprintf(stderr, "kernel_launch: needs a 256-CU device with one resident workgroup per CU (cus %d, per_cu %d)\n", cus, per_cu); grid = -1; return; }
    grid = 256;
  }
  if (grid < 0) return;
  (void)hipMemsetAsync((char*)d_ws + O_CTL, 0, CTL_BYTES, stream);
  Args a{};
  for (int i = 0; i < 22; ++i) a.in[i] = (const float*)d_in[i];
  a.out = (float*)d_out; a.ws = (unsigned char*)d_ws;
#if ONE_LAUNCH
  a.ph_lo = 0; a.ph_hi = HYBRID_CUT;
  hipLaunchKernelGGL(fwd_kernel, dim3(grid), dim3(NTHREADS), LDS_BYTES, stream, a);
#else
#ifdef PHASE_SEQ
  { const int seq[] = {PHASE_SEQ}; for (int i = 0; i < (int)(sizeof(seq) / sizeof(int)); ++i) { a.ph_lo = seq[i]; a.ph_hi = seq[i] + 1; (void)hipMemsetAsync((char*)d_ws + O_CTL, 0, CTL_BYTES, stream); hipLaunchKernelGGL(fwd_kernel, dim3(grid), dim3(NTHREADS), LDS_BYTES, stream, a); } }
#else
  for (int p = 0; p < HYBRID_CUT; ++p) { a.ph_lo = p; a.ph_hi = p + 1; hipLaunchKernelGGL(fwd_kernel, dim3(grid), dim3(NTHREADS), LDS_BYTES, stream, a); }
#endif
#endif
#if HYBRID_CUT < 9
  float* h = (float*)d_out;
  if (HYBRID_CUT <= 5) slow_xattn(stream, d_in, h, (float*)d_ws);
  slow_peer(stream, d_in, h, (float*)d_ws, (float*)d_out);
#endif
}
```
